# Optimizing an MI355X kernel written in HIP

```python
import jax, jax.numpy as jnp
from jax import lax
import numpy as np


D_MODEL = 1024
BATCH = 8
SEQ = 4096
DEPTH = 2

N_META = 16
GRID_W = 64
EPS = 1e-6
N_FOURIER_GROUPS = 4
FOURIER_GROUP_DIM = 64
D_FOURIER = N_FOURIER_GROUPS * FOURIER_GROUP_DIM
N_Q_HEADS = 6
N_KV_HEADS = 2
HEAD_DIM = 128
Q_BLOCK = 128
ROPE_THETA = 10000.0
D_ATTN = N_Q_HEADS * HEAD_DIM
D_KV = N_KV_HEADS * HEAD_DIM
D_IN_AB = D_FOURIER + D_ATTN + 2 * D_KV
D_MIX_AB = D_FOURIER + D_ATTN
N_HGRN_HEADS = 8
HGRN_KEY_DIM = 128
HGRN_VAL_DIM = D_MODEL // N_HGRN_HEADS
D_HGRN_F = N_HGRN_HEADS * HGRN_KEY_DIM
D_HGRN_V = N_HGRN_HEADS * HGRN_VAL_DIM
D_IN_C = 3 * D_HGRN_F + 2 * D_HGRN_V
CHUNK = 64
D_FF = 4 * D_MODEL
N_EVEN = (DEPTH + 1) // 2
N_ODD = DEPTH // 2

kernel_name = 'hybrid_fourier_gqa_hgrn2_encoder'


def rms_norm(x, gain):
    xf = x.astype(jnp.float32)
    y = xf * lax.rsqrt(jnp.mean(xf * xf, axis=-1, keepdims=True) + EPS)
    return (y * gain.astype(jnp.float32)).astype(x.dtype)


def fourier_mix(u):
    B, L, _ = u.shape
    ug = u.reshape(B, L, N_FOURIER_GROUPS, FOURIER_GROUP_DIM).astype(jnp.float32)
    y = jnp.fft.fft2(ug, axes=(1, 3), norm='ortho').real
    return y.reshape(B, L, D_FOURIER).astype(u.dtype)


def axial_rope_angles(n_tokens):
    rows = n_tokens // GRID_W
    row = jnp.repeat(jnp.arange(rows), GRID_W).astype(jnp.float32)
    col = jnp.tile(jnp.arange(GRID_W), rows).astype(jnp.float32)
    n_freq = HEAD_DIM // 4
    inv = ROPE_THETA ** (-jnp.arange(n_freq, dtype=jnp.float32) / n_freq)
    ang = jnp.concatenate([row[:, None] * inv, col[:, None] * inv], axis=-1)
    ang = jnp.concatenate([jnp.zeros((N_META, HEAD_DIM // 2), jnp.float32), ang], axis=0)
    return jnp.cos(ang), jnp.sin(ang)


def apply_rope(x, cos, sin):
    xf = x.astype(jnp.float32)
    half = HEAD_DIM // 2
    x1, x2 = xf[..., :half], xf[..., half:]
    c = cos[None, :, None, :]
    s = sin[None, :, None, :]
    return jnp.concatenate([x1 * c - x2 * s, x2 * c + x1 * s], axis=-1).astype(x.dtype)


def attention(q, k, v):
    B, L = q.shape[0], q.shape[1]
    G = N_Q_HEADS // N_KV_HEADS
    scale = HEAD_DIM ** -0.5

    def attend(qb):
        tq = qb.shape[1]
        qb = qb.reshape(B, tq, N_KV_HEADS, G, HEAD_DIM)
        s = jnp.einsum('bqhgd,bkhd->bhgqk', qb, k).astype(jnp.float32) * scale
        p = jax.nn.softmax(s, axis=-1).astype(v.dtype)
        o = jnp.einsum('bhgqk,bkhd->bqhgd', p, v)
        return o.reshape(B, tq, D_ATTN)

    o_meta = attend(q[:, :N_META])
    n_blk = (L - N_META) // Q_BLOCK
    qr = q[:, N_META:].reshape(B, n_blk, Q_BLOCK, N_Q_HEADS, HEAD_DIM).transpose(1, 0, 2, 3, 4)
    o_real = lax.map(attend, qr)
    o_real = o_real.transpose(1, 0, 2, 3).reshape(B, L - N_META, D_ATTN)
    return jnp.concatenate([o_meta, o_real], axis=1)


def fourier_attention_mixer(h, w_in, q_gain, k_gain, w_out, cos, sin):
    B, L, _ = h.shape
    z = h @ w_in
    u, q, k, v = jnp.split(z, [D_FOURIER, D_FOURIER + D_ATTN, D_FOURIER + D_ATTN + D_KV], axis=-1)
    y_f = fourier_mix(u)
    q = apply_rope(rms_norm(q.reshape(B, L, N_Q_HEADS, HEAD_DIM), q_gain), cos, sin)
    k = apply_rope(rms_norm(k.reshape(B, L, N_KV_HEADS, HEAD_DIM), k_gain), cos, sin)
    v = v.reshape(B, L, N_KV_HEADS, HEAD_DIM)
    y_a = attention(q, k, v)
    return jnp.concatenate([y_f, y_a], axis=-1) @ w_out


def _gla_chunk(S, xs):
    q, k, v, g = xs
    C = q.shape[2]
    b = jnp.cumsum(g, axis=2)
    causal = jnp.tril(jnp.ones((C, C), dtype=bool))
    diff = b[:, :, :, None, :] - b[:, :, None, :, :]
    decay = jnp.exp(jnp.where(causal[None, None, :, :, None], diff, -jnp.inf))
    scores = jnp.einsum('bhtd,bhsd,bhtsd->bhts', q, k, decay)
    o = jnp.einsum('bhts,bhsv->bhtv', scores, v) + jnp.einsum('bhtd,bhdv->bhtv', q * jnp.exp(b), S)
    b_last = b[:, :, -1:, :]
    S_new = jnp.exp(b_last[:, :, 0, :, None]) * S + jnp.einsum('bhsd,bhsv->bhdv', k * jnp.exp(b_last - b), v)
    return S_new, o


def gla_scan(q, k, v, g, S0, chunk):
    B, T, H = q.shape[0], q.shape[1], q.shape[2]
    n = T // chunk

    def to_chunks(a):
        return a.reshape(B, n, chunk, H, a.shape[-1]).transpose(1, 0, 3, 2, 4)

    S, o = lax.scan(_gla_chunk, S0, (to_chunks(q), to_chunks(k), to_chunks(v), to_chunks(g)))
    o = o.transpose(1, 0, 3, 2, 4).reshape(B, T, H, o.shape[-1])
    return o, S


def _hgrn_direction(q, v, f_logit, lb, reverse):
    B, L, _ = f_logit.shape
    f = lb + (1.0 - lb) * jax.nn.sigmoid(f_logit)
    k = (1.0 - f).reshape(B, L, N_HGRN_HEADS, HGRN_KEY_DIM)
    g = jnp.log(f).reshape(B, L, N_HGRN_HEADS, HGRN_KEY_DIM)
    arrays = (q, k, v, g)
    meta = tuple(a[:, :N_META] for a in arrays)
    real = tuple(a[:, N_META:] for a in arrays)
    S0 = jnp.zeros((B, N_HGRN_HEADS, HGRN_KEY_DIM, HGRN_VAL_DIM), jnp.float32)
    if not reverse:
        o_meta, S = gla_scan(*meta, S0, N_META)
        o_real, _ = gla_scan(*real, S, CHUNK)
        return jnp.concatenate([o_meta, o_real], axis=1)
    flip_seg = lambda seg: tuple(jnp.flip(a, axis=1) for a in seg)
    o_real, S = gla_scan(*flip_seg(real), S0, CHUNK)
    o_meta, _ = gla_scan(*flip_seg(meta), S, N_META)
    return jnp.flip(jnp.concatenate([o_real, o_meta], axis=1), axis=1)


def hgrn2_mixer(h, w_in, lb, o_gain, w_out):
    B, L, _ = h.shape
    z = (h @ w_in).astype(jnp.float32)
    q, f_fwd, f_bwd, i, gate = jnp.split(
        z, [D_HGRN_F, 2 * D_HGRN_F, 3 * D_HGRN_F, 3 * D_HGRN_F + D_HGRN_V], axis=-1)
    q = jax.nn.silu(q).reshape(B, L, N_HGRN_HEADS, HGRN_KEY_DIM)
    v = i.reshape(B, L, N_HGRN_HEADS, HGRN_VAL_DIM)
    o = _hgrn_direction(q, v, f_fwd, lb[0], False) + _hgrn_direction(q, v, f_bwd, lb[1], True)
    o = rms_norm(o, o_gain.reshape(N_HGRN_HEADS, HGRN_VAL_DIM)).reshape(B, L, D_HGRN_V)
    o = o * jax.nn.silu(gate)
    return o.astype(h.dtype) @ w_out


def sq_relu_mlp(h, w1, w2):
    return jnp.square(jax.nn.relu(h @ w1)) @ w2


def setup_inputs(seed: int = 0) -> dict:
    key = jax.random.key(seed)
    ks = jax.random.split(key, 16)
    nrm = lambda k, shape, fan_in: jax.random.normal(k, shape, jnp.float32) * (fan_in ** -0.5)
    gain = lambda k, shape: 1.0 + 0.02 * jax.random.normal(k, shape, jnp.float32)
    return {
        'x': jax.random.normal(ks[0], (BATCH, SEQ, D_MODEL), jnp.float32),
        'meta_tokens': jax.random.normal(ks[1], (N_META, D_MODEL), jnp.float32),
        'mix_norm_gain': gain(ks[2], (DEPTH, D_MODEL)),
        'ab_w_in': nrm(ks[3], (N_EVEN, D_MODEL, D_IN_AB), D_MODEL),
        'ab_q_gain': gain(ks[4], (N_EVEN, HEAD_DIM)),
        'ab_k_gain': gain(ks[5], (N_EVEN, HEAD_DIM)),
        'ab_w_out': nrm(ks[6], (N_EVEN, D_MIX_AB, D_MODEL), D_MIX_AB),
        'c_w_in': nrm(ks[7], (N_ODD, D_MODEL, D_IN_C), D_MODEL),
        'c_lb_logits': 0.5 * jax.random.normal(ks[8], (DEPTH, 2, D_HGRN_F), jnp.float32),
        'c_o_gain': gain(ks[9], (N_ODD, D_HGRN_V)),
        'c_w_out': nrm(ks[10], (N_ODD, D_HGRN_V, D_MODEL), D_HGRN_V),
        'mlp_norm_gain': gain(ks[11], (DEPTH, D_MODEL)),
        'mlp_w1': nrm(ks[12], (DEPTH, D_MODEL, D_FF), D_MODEL),
        'mlp_w2': nrm(ks[13], (DEPTH, D_FF, D_MODEL), D_FF),
        'final_norm_gain': gain(ks[14], (D_MODEL,)),
    }


def reference(x, meta_tokens, mix_norm_gain, ab_w_in, ab_q_gain, ab_k_gain, ab_w_out,
              c_w_in, c_lb_logits, c_o_gain, c_w_out, mlp_norm_gain, mlp_w1, mlp_w2,
              final_norm_gain):
    B, n_tok = x.shape[0], x.shape[1]
    cos, sin = axial_rope_angles(n_tok)
    meta = jnp.broadcast_to(meta_tokens.astype(x.dtype)[None], (B, N_META, D_MODEL))
    h = jnp.concatenate([meta, x], axis=1)
    p = jax.nn.softmax(c_lb_logits.astype(jnp.float32), axis=0)
    lower_bounds = jnp.cumsum(p, axis=0) - p[0]
    for layer in range(DEPTH):
        j = layer // 2
        hn = rms_norm(h, mix_norm_gain[layer])
        if layer % 2 == 0:
            h = h + fourier_attention_mixer(hn, ab_w_in[j], ab_q_gain[j], ab_k_gain[j], ab_w_out[j], cos, sin)
        else:
            h = h + hgrn2_mixer(hn, c_w_in[j], lower_bounds[layer], c_o_gain[j], c_w_out[j])
        h = h + sq_relu_mlp(rms_norm(h, mlp_norm_gain[layer]), mlp_w1[layer], mlp_w2[layer])
    return rms_norm(h, final_norm_gain)[:, N_META:]
```

```cpp
#include <hip/hip_runtime.h>
#include <hip/hip_cooperative_groups.h>
#include <hip/hip_bf16.h>
#include <cstdio>
#include <cstdint>
namespace cg = cooperative_groups;
namespace pg8 {
#define PG8_LAS __attribute__((address_space(3)))
typedef unsigned short bf16_t;
typedef short bf16x8 __attribute__((ext_vector_type(8)));
typedef _Float16 f16x8 __attribute__((ext_vector_type(8)));
typedef float f32x4 __attribute__((ext_vector_type(4)));
typedef unsigned u32x4 __attribute__((ext_vector_type(4)));
constexpr int BM = 256, BK = 64, HALF = 128, HTB = HALF * BK * 2  , STAGE_BYTES = 8 * HTB, NXCD = 8, WGM = 4;

__host__ __device__ __forceinline__ int lds_byte(int r, int c) { const int st = (r >> 4) * 2 + (c >> 5), rr = r & 15, cc = c & 31, ob = rr * 64 + cc * 2; return st * 1024 + (ob ^ (((ob >> 9) & 1) << 5)); }
__host__ __device__ __forceinline__ void stage_rc(int b, int& R, int& C) { const int st = b / 1024, sb = b % 1024, swz = sb ^ (((sb >> 9) & 1) << 5); R = (st >> 1) * 16 + swz / 64; C = (st & 1) * 32 + (swz % 64) / 2; }
__host__ __device__ __forceinline__ int perm32(int rho) { const int n = rho >> 4, i = rho & 15; return 8 * (i >> 2) + 4 * n + (i & 3); }

struct Unit { int pm, pn; };
struct Gemm { const bf16_t* A; const bf16_t* Bt; int M, N, K; };

struct StaticOrder {
    int nM, nN, nwg, G, c;
    __host__ __device__ void init(int M, int N, int G_, int c_) { nM = M / BM; nN = N / BM; nwg = nM * nN; G = G_; c = c_; }
    __host__ __device__ bool next(int i, Unit& u) const {
        const long L = (long)i * G + c; if (L >= nwg) return false;
        int wgid = (int)L; { const int q = nwg / NXCD, r = nwg % NXCD, xcd = wgid % NXCD, off = wgid / NXCD; wgid = (xcd < r ? xcd * (q + 1) : r * (q + 1) + (xcd - r) * q) + off; }
        const int nig = WGM * nN, gid = wgid / nig, fm = gid * WGM, gsz = (nM - fm) < WGM ? (nM - fm) : WGM;
        u.pm = fm + ((wgid % nig) % gsz); u.pn = (wgid % nig) / gsz; return true;
    }
    __device__ __forceinline__ void a_ready(const Unit&) const {}
    __device__ __forceinline__ void done(const Unit&) const {}
};

__device__ __forceinline__ unsigned cvt_pk_bf16(float lo, float hi) { unsigned r; asm volatile("v_cvt_pk_bf16_f32 %0, %1, %2" : "=v"(r) : "v"(lo), "v"(hi)); return r; }
typedef float f32x2 __attribute__((ext_vector_type(2)));
template <class Epi, class Sched, bool ALIGN_EPI = false, bool SP2 = false>
__device__ __forceinline__ void gemm_phase(PG8_LAS unsigned char* lds, const Gemm g, const Sched& S, const Epi& E) {
    int tid_o = threadIdx.x; asm volatile("" : "+v"(tid_o));
    const int tid = tid_o, wid = __builtin_amdgcn_readfirstlane(tid >> 6), lane = tid & 63, wr = wid >> 2, wc = wid & 3, fr = lane & 15, fq = lane >> 4;
    const int K = g.K, nt = K / BK;
    unsigned voffA[2], voffB[2];
#pragma unroll
    for (int i = 0; i < 2; ++i) { int R, C; stage_rc(tid * 16 + i * 8192, R, C); const int Rb = Epi::PERM ? ((R & ~31) + perm32(R & 31)) : R;
        voffA[i] = (unsigned)(R * K + C) * 2u; voffB[i] = (unsigned)(Rb * K + C) * 2u; }
    const size_t kstep = (size_t)(BK * 2);
    const size_t hstep = (size_t)HALF * K * 2;
    const size_t tstep = 2 * hstep;
    const unsigned ldsw = (unsigned)wid * 1024u;
    const int aoff = lds_byte(wr * 64 + fr, fq * 8), boff = lds_byte(wc * 32 + fr, fq * 8);
#define PG8_SA(b, h) (((b) * 2 + (h)) * HTB)
#define PG8_SB(b, h) ((4 + (b) * 2 + (h)) * HTB)
#define PG8_STAGE(bufoff, gbase, voff) do { _Pragma("unroll") for (int _i = 0; _i < 2; ++_i) \
        __builtin_amdgcn_global_load_lds((const unsigned*)((const char*)(gbase) + (voff)[_i]), (PG8_LAS unsigned*)(lds + (bufoff) + ldsw + _i * 8192), 16, 0, 0); } while (0)
#define PG8_LDA(dst, b, h) do { _Pragma("unroll") for (int m = 0; m < 4; ++m) _Pragma("unroll") for (int k = 0; k < 2; ++k) dst[m][k] = *(const PG8_LAS bf16x8*)(lds + PG8_SA(b, h) + aoff + m * 2048 + k * 1024); } while (0)
#define PG8_LDB(dst, b, h) do { _Pragma("unroll") for (int n = 0; n < 2; ++n) _Pragma("unroll") for (int k = 0; k < 2; ++k) dst[n][k] = *(const PG8_LAS bf16x8*)(lds + PG8_SB(b, h) + boff + n * 2048 + k * 1024); } while (0)
#define PG8_MMA(ai, bj, At, Bt) do { __builtin_amdgcn_s_setprio(1); _Pragma("unroll") for (int m = 0; m < 4; ++m) _Pragma("unroll") for (int n = 0; n < 2; ++n) _Pragma("unroll") for (int k = 0; k < 2; ++k) \
        acc[ai][bj][m][n] = __builtin_amdgcn_mfma_f32_16x16x32_f16(__builtin_bit_cast(pg8::f16x8, Bt[n][k]), __builtin_bit_cast(pg8::f16x8, At[m][k]), acc[ai][bj][m][n], 0, 0, 0); __builtin_amdgcn_s_setprio(0); } while (0)
#define PG8_WAIT_V(n) asm volatile("s_waitcnt vmcnt(" #n ")" ::: "memory")
#define PG8_WAIT_L(n) asm volatile("s_waitcnt lgkmcnt(" #n ")" ::: "memory")
#define PG8_BAR __builtin_amdgcn_s_barrier()
#define PG8_SCHED __builtin_amdgcn_sched_barrier(0)
    Unit cur, nxt; int ui = 0;
    if (!S.next(0, cur)) return;
    f32x4 acc[2][2][4][2];
#pragma unroll
    for (int a = 0; a < 2; ++a)
#pragma unroll
        for (int b = 0; b < 2; ++b)
#pragma unroll
            for (int m = 0; m < 4; ++m)
#pragma unroll
                for (int n = 0; n < 2; ++n) acc[a][b][m][n] = (f32x4){0.f, 0.f, 0.f, 0.f};
    bf16x8 At[4][2], B0[2][2], B1[2][2];
    const char* cA = (const char*)g.A + (size_t)cur.pm * tstep; const char* cB = (const char*)g.Bt + (size_t)cur.pn * tstep;
    S.a_ready(cur);
    if constexpr (SP2) {
        PG8_STAGE(PG8_SB(0, 0), cB, voffB); PG8_STAGE(PG8_SB(0, 1), cB + hstep, voffB); PG8_STAGE(PG8_SA(0, 0), cA, voffA); PG8_STAGE(PG8_SA(0, 1), cA + hstep, voffA);
        if (wr == 1) PG8_BAR;
        PG8_WAIT_V(2); PG8_BAR;
        PG8_STAGE(PG8_SB(1, 0), cB + kstep, voffB); PG8_STAGE(PG8_SA(1, 0), cA + kstep, voffA); PG8_STAGE(PG8_SB(1, 1), cB + hstep + kstep, voffB);
        PG8_WAIT_V(6); PG8_BAR;
    } else {
        PG8_STAGE(PG8_SB(0, 0), cB, voffB); PG8_STAGE(PG8_SA(0, 0), cA, voffA); PG8_STAGE(PG8_SB(0, 1), cB + hstep, voffB); PG8_STAGE(PG8_SA(0, 1), cA + hstep, voffA);
        if (wr == 1) PG8_BAR;
        PG8_WAIT_V(4); PG8_BAR;
        PG8_STAGE(PG8_SB(1, 0), cB + kstep, voffB); PG8_STAGE(PG8_SA(1, 0), cA + kstep, voffA); PG8_STAGE(PG8_SB(1, 1), cB + hstep + kstep, voffB);
        PG8_WAIT_V(6); PG8_BAR;
    }
    for (;;) {
        const bool has_next = S.next(ui + 1, nxt);
        const char* nA = has_next ? (const char*)g.A + (size_t)nxt.pm * tstep : cA; const char* nB = has_next ? (const char*)g.Bt + (size_t)nxt.pn * tstep : cB;
        for (int t = 0; t < nt; t += 2) {
            const bool last = (t == nt - 2);
            const char* a1 = cA + (size_t)(t + 1) * kstep;
            const char* a2 = last ? nA : cA + (size_t)(t + 2) * kstep; const char* b2 = last ? nB : cB + (size_t)(t + 2) * kstep;
            const char* a3 = a2 + kstep; const char* b3 = b2 + kstep;
            if (last && has_next) S.a_ready(nxt);
            if constexpr (SP2) {
            PG8_LDB(B0, 0, 0); PG8_LDB(B1, 0, 1); PG8_SCHED; PG8_LDA(At, 0, 0); PG8_STAGE(PG8_SA(1, 1), a1 + hstep, voffA);
            PG8_WAIT_V(8); PG8_WAIT_L(0); PG8_BAR; PG8_MMA(0, 0, At, B0); PG8_MMA(0, 1, At, B1); PG8_BAR; PG8_SCHED;
            PG8_LDA(At, 0, 1); PG8_STAGE(PG8_SB(0, 0), b2, voffB); PG8_STAGE(PG8_SB(0, 1), b2 + hstep, voffB); PG8_STAGE(PG8_SA(0, 0), a2, voffA);
            PG8_WAIT_V(8); PG8_WAIT_L(0); PG8_BAR; PG8_MMA(1, 0, At, B0); PG8_MMA(1, 1, At, B1); PG8_BAR; PG8_SCHED;
            PG8_LDB(B0, 1, 0); PG8_LDB(B1, 1, 1); PG8_SCHED; PG8_LDA(At, 1, 0); PG8_STAGE(PG8_SA(0, 1), a2 + hstep, voffA);
            PG8_WAIT_V(8); PG8_WAIT_L(0); PG8_BAR; PG8_MMA(0, 0, At, B0); PG8_MMA(0, 1, At, B1); PG8_BAR; PG8_SCHED;
            PG8_LDA(At, 1, 1); PG8_STAGE(PG8_SB(1, 0), b3, voffB); PG8_STAGE(PG8_SB(1, 1), b3 + hstep, voffB); PG8_STAGE(PG8_SA(1, 0), a3, voffA);
            PG8_WAIT_V(8); PG8_WAIT_L(0); PG8_BAR; PG8_MMA(1, 0, At, B0); PG8_MMA(1, 1, At, B1); PG8_BAR; PG8_SCHED;
            } else {
            PG8_LDB(B0, 0, 0); PG8_SCHED; PG8_LDA(At, 0, 0); PG8_STAGE(PG8_SA(1, 1), a1 + hstep, voffA);
            PG8_WAIT_L(8); PG8_BAR; PG8_WAIT_L(0); PG8_MMA(0, 0, At, B0); PG8_BAR; PG8_SCHED;
            PG8_LDB(B1, 0, 1); PG8_STAGE(PG8_SB(0, 0), b2, voffB);
            PG8_BAR; PG8_WAIT_L(0); PG8_MMA(0, 1, At, B1); PG8_BAR;
            PG8_LDA(At, 0, 1); PG8_STAGE(PG8_SA(0, 0), a2, voffA);
            PG8_BAR; PG8_WAIT_L(0); PG8_MMA(1, 0, At, B0); PG8_BAR; PG8_SCHED;
            PG8_STAGE(PG8_SB(0, 1), b2 + hstep, voffB);
            PG8_WAIT_V(6); PG8_BAR; PG8_MMA(1, 1, At, B1); PG8_BAR;
            PG8_LDB(B0, 1, 0); PG8_SCHED; PG8_LDA(At, 1, 0); PG8_STAGE(PG8_SA(0, 1), a2 + hstep, voffA);
            PG8_WAIT_L(8); PG8_BAR; PG8_WAIT_L(0); PG8_MMA(0, 0, At, B0); PG8_BAR; PG8_SCHED;
            PG8_LDB(B1, 1, 1); PG8_STAGE(PG8_SB(1, 0), b3, voffB);
            PG8_BAR; PG8_WAIT_L(0); PG8_MMA(0, 1, At, B1); PG8_BAR;
            PG8_LDA(At, 1, 1); PG8_STAGE(PG8_SA(1, 0), a3, voffA);
            PG8_BAR; PG8_WAIT_L(0); PG8_MMA(1, 0, At, B0); PG8_BAR; PG8_SCHED;
            PG8_STAGE(PG8_SB(1, 1), b3 + hstep, voffB);
            PG8_WAIT_V(6); PG8_BAR; PG8_MMA(1, 1, At, B1); PG8_BAR;
            }
        }
        if constexpr (ALIGN_EPI) { if (wr == 0) PG8_BAR; }
        if constexpr (!Epi::AFTER_DRAIN) { E(acc, cur, wr, wc, fr, fq); S.done(cur); }
        if (!has_next) break;
#pragma unroll
        for (int a = 0; a < 2; ++a)
#pragma unroll
            for (int b = 0; b < 2; ++b)
#pragma unroll
                for (int m = 0; m < 4; ++m)
#pragma unroll
                    for (int n = 0; n < 2; ++n) acc[a][b][m][n] = (f32x4){0.f, 0.f, 0.f, 0.f};
        cur = nxt; cA = nA; cB = nB; ++ui;
        if constexpr (ALIGN_EPI) { if (wr == 1) PG8_BAR; }
    }
    PG8_WAIT_V(0);
    if constexpr (!ALIGN_EPI) { if (wr == 0) PG8_BAR; }
    PG8_BAR;
    if constexpr (Epi::AFTER_DRAIN) { E.fused(acc, cur, wr, wc, fr, fq, lds, wid, lane); S.done(cur); }
#undef PG8_SA
#undef PG8_SB
#undef PG8_STAGE
#undef PG8_LDA
#undef PG8_LDB
#undef PG8_MMA
#undef PG8_WAIT_V
#undef PG8_WAIT_L
#undef PG8_BAR
#undef PG8_SCHED
}
}

typedef unsigned short bf16_t;
typedef short bf16x8 __attribute__((ext_vector_type(8)));
typedef short s16x4 __attribute__((ext_vector_type(4)));
typedef float f32x4 __attribute__((ext_vector_type(4)));
typedef float f32x16 __attribute__((ext_vector_type(16)));
typedef unsigned u32x4 __attribute__((ext_vector_type(4)));
typedef unsigned u32x2 __attribute__((ext_vector_type(2)));
#define LAS3 __attribute__((address_space(3)))

constexpr int DM = 1024, NB = 8, SEQ = 4096, LT = 4112, T = NB * LT, TP = 33024, NREAL = NB * SEQ;
constexpr int NQKV = 1280, DFF = 4096, NC = 5120;
constexpr int LK = 4160, KF = 2 * LK, MF = 4352;
constexpr float EPS = 1e-6f;
constexpr size_t MiB = 1u << 20;
constexpr size_t WS_ROWSS = 0;
constexpr size_t WS_LB = 704512;
constexpr size_t WS_BAR = 720896;
constexpr size_t WS_HMETA = 1 * MiB;
constexpr size_t W_UCS = 2 * MiB;
constexpr size_t W_QKV = W_UCS + 1 * MiB;
constexpr size_t W_O0 = W_QKV + 2560 * 1024;
constexpr size_t W_1_0 = W_O0 + 4 * MiB;
constexpr size_t W_2_0 = W_1_0 + 16 * MiB;
constexpr size_t W_C = W_2_0 + 16 * MiB;
constexpr size_t W_END = W_C + 10 * MiB;
constexpr size_t WS_HB = 52 * MiB;
constexpr size_t WS_Y = 117 * MiB;
constexpr size_t WS_BIG = 182 * MiB;
constexpr size_t WS_ZQ = WS_BIG, WS_UCST = WS_BIG + 81 * MiB, WS_ADFT = WS_BIG + 114 * MiB, WS_HID = WS_BIG, WS_Z1 = WS_BIG;
constexpr size_t WS_NEED = WS_BIG + (size_t)TP * NC * 2;
static_assert(W_END <= WS_HB && WS_HB + (size_t)TP * DM * 2 <= WS_Y && WS_Y + (size_t)TP * DM * 2 <= WS_BIG, "ws map");
static_assert(WS_ZQ + (size_t)TP * NQKV * 2 <= WS_UCST && WS_UCST + (size_t)2048 * KF * 2 <= WS_ADFT && WS_ADFT + (size_t)MF * KF * 2 <= WS_NEED, "ws map 2");
static_assert(WS_NEED <= 512 * MiB, "ws size");
constexpr int LDS_BYTES = 147456;

struct Params {
    const float* x; const float* meta; const float* mix_gain; const float* ab_w_in; const float* ab_q_gain; const float* ab_k_gain; const float* ab_w_out;
    const float* c_w_in; const float* c_lb; const float* c_o_gain; const float* c_w_out; const float* mlp_gain; const float* mlp_w1; const float* mlp_w2; const float* final_gain;
    float* out; unsigned char* ws;
};

typedef _Float16 f16x2 __attribute__((ext_vector_type(2)));
typedef _Float16 f16x8 __attribute__((ext_vector_type(8)));
typedef float f32x2 __attribute__((ext_vector_type(2)));
__device__ __forceinline__ unsigned pk2(float lo, float hi) { const f32x2 v = {lo, hi}; const f16x2 h = __builtin_convertvector(v, f16x2); return __builtin_bit_cast(unsigned, h); }
__device__ __forceinline__ bf16_t f2b(float v) { const _Float16 h = (_Float16)v; return __builtin_bit_cast(unsigned short, h); }
__device__ __forceinline__ float b2f(bf16_t v) { return (float)__builtin_bit_cast(_Float16, v); }
__device__ __forceinline__ float blo(unsigned w) { return b2f((bf16_t)(w & 0xffffu)); }
__device__ __forceinline__ float bhi(unsigned w) { return b2f((bf16_t)(w >> 16)); }
__device__ __forceinline__ unsigned pk2_bf(float lo, float hi) { unsigned r; asm volatile("v_cvt_pk_bf16_f32 %0, %1, %2" : "=v"(r) : "v"(lo), "v"(hi)); return r; }
__device__ __forceinline__ bf16_t f2bf(float v) { return (bf16_t)(pk2_bf(v, v) & 0xffffu); }
__device__ __forceinline__ f32x16 mfma32(bf16x8 a, bf16x8 b, f32x16 c) { return __builtin_amdgcn_mfma_f32_32x32x16_f16(__builtin_bit_cast(f16x8, a), __builtin_bit_cast(f16x8, b), c, 0, 0, 0); }
__device__ __forceinline__ const Params& KP() { const void* p = (const void*)__builtin_amdgcn_kernarg_segment_ptr(); asm volatile("" : "+s"(p)); return *(const Params*)p; }
__device__ __forceinline__ int otid() { int t = threadIdx.x; asm volatile("" : "+v"(t)); return t; }
__device__ __forceinline__ int crow(int r, int hi) { return (r & 3) + 8 * (r >> 2) + 4 * hi; }
__device__ __forceinline__ float wave_sum(float v) {
#pragma unroll
    for (int o = 32; o > 0; o >>= 1) v += __shfl_xor(v, o);
    return v;
}
__device__ __forceinline__ float rstd_of(float ss) { return rsqrtf(ss * (1.0f / 1024.0f) + EPS); }
template <int ACT> struct EpiAct {
    static constexpr bool PERM = true, AFTER_DRAIN = false;
    bf16_t* O; int ldc; const float* rowss;
    __device__ __forceinline__ void operator()(const f32x4 (&acc)[2][2][4][2], const pg8::Unit& u, int wr, int wc, int fr, int fq) const {
        const int row0 = u.pm * 256 + wr * 64 + fr, col0 = u.pn * 256 + wc * 32 + 8 * fq;
        float rsv[2][4];
#pragma unroll
        for (int ai = 0; ai < 2; ++ai)
#pragma unroll
            for (int m = 0; m < 4; ++m) rsv[ai][m] = rowss[row0 + ai * 128 + m * 16];
#pragma unroll
        for (int ai = 0; ai < 2; ++ai)
#pragma unroll
            for (int m = 0; m < 4; ++m) rsv[ai][m] = rstd_of(rsv[ai][m]);
#pragma unroll
        for (int ai = 0; ai < 2; ++ai)
#pragma unroll
            for (int m = 0; m < 4; ++m) {
                const int row = row0 + ai * 128 + m * 16; const float rs = rsv[ai][m];
                bf16_t* rowp = O + (size_t)row * ldc + col0;
#pragma unroll
                for (int bj = 0; bj < 2; ++bj) {
                    f32x4 v0 = acc[ai][bj][m][0] * rs, v1 = acc[ai][bj][m][1] * rs;
                    if (ACT == 1) {
#pragma unroll
                        for (int j = 0; j < 4; ++j) { float a = fmaxf(v0[j], 0.f), b = fmaxf(v1[j], 0.f); v0[j] = a * a; v1[j] = b * b; }
                    }
                    u32x4 w; w.x = pk2(v0[0], v0[1]); w.y = pk2(v0[2], v0[3]); w.z = pk2(v1[0], v1[1]); w.w = pk2(v1[2], v1[3]);
                    __builtin_nontemporal_store(w, (u32x4*)(rowp + bj * 128));
                }
            }
    }
};
struct EpiUcs {
    static constexpr bool PERM = true, AFTER_DRAIN = false;
    bf16_t* U; const float* rowss;
    __device__ __forceinline__ void operator()(const f32x4 (&acc)[2][2][4][2], const pg8::Unit& u, int wr, int wc, int fr, int fq) const {
        const int part = u.pm;
        f32x4 sv[2][2];
#pragma unroll
        for (int bj = 0; bj < 2; ++bj) { const int t0 = u.pn * 256 + bj * 128 + wc * 32 + 8 * fq; sv[bj][0] = *(const f32x4*)(rowss + t0); sv[bj][1] = *(const f32x4*)(rowss + t0 + 4); }
#pragma unroll
        for (int bj = 0; bj < 2; ++bj) {
            const int t0 = u.pn * 256 + bj * 128 + wc * 32 + 8 * fq;
            if (t0 < T) {
                int b, p; if (t0 < NREAL) { b = t0 >> 12; p = 16 + (t0 & 4095); } else { b = (t0 - NREAL) >> 4; p = (t0 - NREAL) & 15; }
                const f32x4 s0 = sv[bj][0], s1 = sv[bj][1];
                f32x4 r0, r1; r0[0] = rstd_of(s0[0]); r0[1] = rstd_of(s0[1]); r0[2] = rstd_of(s0[2]); r0[3] = rstd_of(s0[3]); r1[0] = rstd_of(s1[0]); r1[1] = rstd_of(s1[1]); r1[2] = rstd_of(s1[2]); r1[3] = rstd_of(s1[3]);
#pragma unroll
                for (int ai = 0; ai < 2; ++ai)
#pragma unroll
                    for (int m = 0; m < 4; ++m) {
                        const int c = ai * 128 + wr * 64 + m * 16 + fr;
                        const f32x4 v0 = acc[ai][bj][m][0] * r0, v1 = acc[ai][bj][m][1] * r1;
                        u32x4 w; w.x = pk2(v0[0], v0[1]); w.y = pk2(v0[2], v0[3]); w.z = pk2(v1[0], v1[1]); w.w = pk2(v1[2], v1[3]);
                        __builtin_nontemporal_store(w, (u32x4*)(U + (size_t)(b * 256 + c) * KF + part * LK + p));
                    }
            }
        }
    }
};
struct EpiFour {
    static constexpr bool PERM = true, AFTER_DRAIN = false;
    bf16_t* Y;
    __device__ __forceinline__ void operator()(const f32x4 (&acc)[2][2][4][2], const pg8::Unit& u, int wr, int wc, int fr, int fq) const {
        const int row0 = u.pm * 256 + wr * 64 + fr, col0 = wc * 32 + 8 * fq;
#pragma unroll
        for (int ai = 0; ai < 2; ++ai)
#pragma unroll
            for (int m = 0; m < 4; ++m) {
                const int lp = row0 + ai * 128 + m * 16;
                if (lp < LT) {
                    bf16_t* rowp = Y + (size_t)(lp < 16 ? NREAL + u.pn * 16 + lp : u.pn * SEQ + lp - 16) * DM + col0;
#pragma unroll
                    for (int bj = 0; bj < 2; ++bj) {
                        const f32x4 v0 = acc[ai][bj][m][0], v1 = acc[ai][bj][m][1];
                        u32x4 w; w.x = pk2(v0[0], v0[1]); w.y = pk2(v0[2], v0[3]); w.z = pk2(v1[0], v1[1]); w.w = pk2(v1[2], v1[3]);
                        __builtin_nontemporal_store(w, (u32x4*)(rowp + bj * 128));
                    }
                }
            }
    }
};
struct EpiHgrn {
    static constexpr bool PERM = true, AFTER_DRAIN = false;
    bf16_t* O; const float* rowss; const float* lb;
    template <int MODE>
    __device__ __forceinline__ void body(const f32x4 (&acc)[2][2][4][2], const float (&rsv)[2][4], const f32x4 (&lbv)[2][2], int row0, int col0) const {
#pragma unroll
        for (int ai = 0; ai < 2; ++ai)
#pragma unroll
            for (int m = 0; m < 4; ++m) {
                const int row = row0 + ai * 128 + m * 16; const float rs = rsv[ai][m];
                bf16_t* rowp = O + (size_t)row * NC + col0;
#pragma unroll
                for (int bj = 0; bj < 2; ++bj) {
                    f32x4 v[2]; v[0] = acc[ai][bj][m][0] * rs; v[1] = acc[ai][bj][m][1] * rs;
                    if (MODE != 2) {
#pragma unroll
                        for (int n = 0; n < 2; ++n)
#pragma unroll
                            for (int j = 0; j < 4; ++j) {
                                const float x = v[n][j];
                                if (MODE == 0) v[n][j] = x * __builtin_amdgcn_rcpf(1.0f + __expf(-x));
                                else v[n][j] = (1.0f - lbv[bj][n][j]) * __builtin_amdgcn_rcpf(1.0f + __expf(x));
                            }
                    }
                    u32x4 w; w.x = pk2(v[0][0], v[0][1]); w.y = pk2(v[0][2], v[0][3]); w.z = pk2(v[1][0], v[1][1]); w.w = pk2(v[1][2], v[1][3]);
                    __builtin_nontemporal_store(w, (u32x4*)(rowp + bj * 128));
                }
            }
    }
    __device__ __forceinline__ void operator()(const f32x4 (&acc)[2][2][4][2], const pg8::Unit& u, int wr, int wc, int fr, int fq) const {
        const int typ = u.pn >> 2;
        const int row0 = u.pm * 256 + wr * 64 + fr, col0 = u.pn * 256 + wc * 32 + 8 * fq;
        f32x4 lbv[2][2];
#pragma unroll
        for (int bj = 0; bj < 2; ++bj) {
            if (typ == 1 || typ == 2) { const float* lp = lb + (col0 - 1024 + bj * 128); lbv[bj][0] = *(const f32x4*)lp; lbv[bj][1] = *(const f32x4*)(lp + 4); }
            else { lbv[bj][0] = (f32x4){0.f, 0.f, 0.f, 0.f}; lbv[bj][1] = lbv[bj][0]; }
        }
        float rsv[2][4];
#pragma unroll
        for (int ai = 0; ai < 2; ++ai)
#pragma unroll
            for (int m = 0; m < 4; ++m) rsv[ai][m] = rowss[row0 + ai * 128 + m * 16];
#pragma unroll
        for (int ai = 0; ai < 2; ++ai)
#pragma unroll
            for (int m = 0; m < 4; ++m) rsv[ai][m] = rstd_of(rsv[ai][m]);
        if (typ == 3) body<2>(acc, rsv, lbv, row0, col0);
        else if (typ == 1 || typ == 2) body<1>(acc, rsv, lbv, row0, col0);
        else body<0>(acc, rsv, lbv, row0, col0);
    }
};
struct EpiRes {
    static constexpr bool PERM = true, AFTER_DRAIN = false;
    bf16_t* HB; float* rowss_next;
    __device__ __forceinline__ void operator()(const f32x4 (&acc)[2][2][4][2], const pg8::Unit& u, int wr, int wc, int fr, int fq) const {
        const int row0 = u.pm * 256 + wr * 64 + fr, col0 = u.pn * 256 + wc * 32 + 8 * fq;
#pragma unroll
        for (int ai = 0; ai < 2; ++ai)
#pragma unroll
            for (int m = 0; m < 4; ++m) {
                const int row = row0 + ai * 128 + m * 16;
                float ss = 0.f;
                {
                    bf16_t* bp = HB + (size_t)row * DM + col0;
                    const u32x4 o0 = *(const u32x4*)bp, o1 = *(const u32x4*)(bp + 128);
#pragma unroll
                    for (int bj = 0; bj < 2; ++bj) {
                        const u32x4 o = bj ? o1 : o0;
                        const f32x4 a0 = acc[ai][bj][m][0], a1 = acc[ai][bj][m][1];
                        u32x4 w;
                        w.x = pk2(blo(o.x) + a0[0], bhi(o.x) + a0[1]); w.y = pk2(blo(o.y) + a0[2], bhi(o.y) + a0[3]);
                        w.z = pk2(blo(o.z) + a1[0], bhi(o.z) + a1[1]); w.w = pk2(blo(o.w) + a1[2], bhi(o.w) + a1[3]);
                        __builtin_nontemporal_store(w, (u32x4*)(bp + bj * 128));
                        const float h0 = blo(w.x), h1 = bhi(w.x), h2 = blo(w.y), h3 = bhi(w.y), h4 = blo(w.z), h5 = bhi(w.z), h6 = blo(w.w), h7 = bhi(w.w);
                        ss += ((h0 * h0 + h1 * h1) + (h2 * h2 + h3 * h3)) + ((h4 * h4 + h5 * h5) + (h6 * h6 + h7 * h7));
                    }
                }
                ss += __shfl_xor(ss, 16); ss += __shfl_xor(ss, 32);
                if (fq == 0) atomicAdd(rowss_next + row, ss);
            }
    }
};

struct EpiDummy {
    static constexpr bool PERM = true, AFTER_DRAIN = false;
    float* sink;
    __device__ __forceinline__ void operator()(const f32x4 (&acc)[2][2][4][2], const pg8::Unit& u, int wr, int wc, int fr, int fq) const {
        if (sink) { f32x4 t = {0.f, 0.f, 0.f, 0.f};
#pragma unroll
            for (int a = 0; a < 2; ++a)
#pragma unroll
                for (int b = 0; b < 2; ++b)
#pragma unroll
                    for (int m = 0; m < 4; ++m) { t += acc[a][b][m][0]; t += acc[a][b][m][1]; }
            *(f32x4*)(sink + (size_t)(u.pm * 4 + u.pn) * 2048 + (wr * 4 + wc) * 256 + (fr * 4 + fq) * 4) = t; }
    }
};
template <class Epi>
__device__ __forceinline__ void meta_gemm(const bf16_t* __restrict__ A, int lda, const bf16_t* __restrict__ Bt, int K, int N, const Epi& E, unsigned char* lds) {
    const int tid = otid(), wid = tid >> 6, lane = tid & 63, l16 = lane & 15, q = lane >> 4;
    float* red = (float*)lds;
    const int ks = K >> 3;
    for (int g = blockIdx.x; g < (N >> 4); g += gridDim.x) {
        const bf16_t* bp = Bt + (size_t)(16 * g + l16) * K + wid * ks + 8 * q;
        const bf16_t* ap = A + (size_t)l16 * lda + wid * ks + 8 * q;
        f32x4 acc[8];
#pragma unroll
        for (int rb = 0; rb < 8; ++rb) acc[rb] = (f32x4){0.f, 0.f, 0.f, 0.f};
#pragma unroll 2
        for (int k = 0; k < ks; k += 32) {
            const f16x8 bf = __builtin_bit_cast(f16x8, *(const bf16x8*)(bp + k));
#pragma unroll
            for (int rb = 0; rb < 8; ++rb)
                acc[rb] = __builtin_amdgcn_mfma_f32_16x16x32_f16(__builtin_bit_cast(f16x8, *(const bf16x8*)(ap + (size_t)(16 * rb) * lda + k)), bf, acc[rb], 0, 0, 0);
        }
#pragma unroll
        for (int rb = 0; rb < 8; ++rb) *(f32x4*)(red + ((wid * 8 + rb) * 64 + lane) * 4) = acc[rb];
        __syncthreads();
        f32x4 sum = {0.f, 0.f, 0.f, 0.f};
#pragma unroll
        for (int w2 = 0; w2 < 8; ++w2) sum += *(const f32x4*)(red + ((w2 * 8 + wid) * 64 + lane) * 4);
        E(NREAL + 16 * wid + 4 * q, 16 * g + l16, sum);
        __syncthreads();
    }
}
struct MetaRes {
    bf16_t* HB; float* rowss_next;
    __device__ __forceinline__ void operator()(int row0, int col, const f32x4& acc) const {
#pragma unroll
        for (int i = 0; i < 4; ++i) {
            bf16_t* p = HB + (size_t)(row0 + i) * DM + col;
            const bf16_t hn = f2b(b2f(*p) + acc[i]); *p = hn;
            float ss = b2f(hn); ss *= ss;
            ss += __shfl_xor(ss, 1); ss += __shfl_xor(ss, 2); ss += __shfl_xor(ss, 4); ss += __shfl_xor(ss, 8);
            if ((threadIdx.x & 15) == 0) atomicAdd(rowss_next + row0 + i, ss);
        }
    }
};
struct MetaUp {
    bf16_t* O; const float* rowss;
    __device__ __forceinline__ void operator()(int row0, int col, const f32x4& acc) const {
#pragma unroll
        for (int i = 0; i < 4; ++i) { const float v = fmaxf(acc[i] * rstd_of(rowss[row0 + i]), 0.f); O[(size_t)(row0 + i) * DFF + col] = f2b(v * v); }
    }
};
struct MetaHgrn {
    bf16_t* O; const float* rowss; const float* lb;
    __device__ __forceinline__ void operator()(int row0, int col, const f32x4& acc) const {
        const int typ = col >> 10;
        const float l = (typ == 1 || typ == 2) ? lb[col - 1024] : 0.f;
#pragma unroll
        for (int i = 0; i < 4; ++i) {
            const float x = acc[i] * rstd_of(rowss[row0 + i]); float r;
            if (typ == 0 || typ == 4) r = x * __builtin_amdgcn_rcpf(1.0f + __expf(-x));
            else if (typ == 3) r = x;
            else r = (1.0f - l) * __builtin_amdgcn_rcpf(1.0f + __expf(x));
            O[(size_t)(row0 + i) * NC + col] = f2b(r);
        }
    }
};

__device__ __forceinline__ void gen_adft(const Params& P, int bx, int G) {
    const int tid = otid(); unsigned char* ws = P.ws;
    const long gtid = (long)bx * 512 + tid, gthreads = (long)G * 512;
    {
        bf16_t* A = (bf16_t*)(ws + WS_ADFT);
        const long nch = (long)MF * (KF / 8);
        for (long ci = gtid; ci < nch; ci += gthreads) {
            const int lp = (int)(ci / (KF / 8)); const int cj = (int)(ci - (long)lp * (KF / 8));
            const int j0 = cj * 8; const int part = j0 >= LK ? 1 : 0; const int l0 = j0 - part * LK;
            u32x4 w = {0u, 0u, 0u, 0u};
            if (lp < LT && l0 < LT) {
                int mm = (int)(((long)lp * l0) % LT);
                float v[8];
#pragma unroll
                for (int e = 0; e < 8; ++e) {
                    const float rev = (float)mm * (1.0f / (float)LT);
                    v[e] = part ? -__builtin_amdgcn_sinf(rev) : __builtin_amdgcn_cosf(rev);
                    mm += lp; if (mm >= LT) mm -= LT;
                }
                w.x = pk2(v[0], v[1]); w.y = pk2(v[2], v[3]); w.z = pk2(v[4], v[5]); w.w = pk2(v[6], v[7]);
            }
            __builtin_nontemporal_store(w, (u32x4*)(A + (size_t)lp * KF + j0));
        }
    }
}

__device__ __forceinline__ void weight_jobs(const Params& P, unsigned char* lds, int job_lo, int job_hi, int bx, int G) {
    const int tid = otid();
    unsigned char* ws = P.ws;
    float* tile = (float*)lds;
#pragma nounroll
    for (int job = job_lo; job < job_hi; ++job) {
        const float* src; int ld, coff, K, N; bf16_t* dst; const float* gain;
        switch (job) {
            case 0: src = P.ab_w_in; ld = 1536; coff = 256; K = 1024; N = 1280; dst = (bf16_t*)(ws + W_QKV); gain = P.mix_gain; break;
            case 1: src = P.ab_w_out; ld = 1024; coff = 0; K = 1024; N = 1024; dst = (bf16_t*)(ws + W_O0); gain = nullptr; break;
            case 2: src = P.mlp_w1; ld = 4096; coff = 0; K = 1024; N = 4096; dst = (bf16_t*)(ws + W_1_0); gain = P.mlp_gain; break;
            case 3: src = P.mlp_w1 + (size_t)1024 * 4096; ld = 4096; coff = 0; K = 1024; N = 4096; dst = (bf16_t*)(ws + W_1_0 + 8 * MiB); gain = P.mlp_gain + 1024; break;
            case 4: src = P.mlp_w2; ld = 1024; coff = 0; K = 4096; N = 1024; dst = (bf16_t*)(ws + W_2_0); gain = nullptr; break;
            case 5: src = P.mlp_w2 + (size_t)4096 * 1024; ld = 1024; coff = 0; K = 4096; N = 1024; dst = (bf16_t*)(ws + W_2_0 + 8 * MiB); gain = nullptr; break;
            case 6: src = P.c_w_in; ld = 5120; coff = 0; K = 1024; N = 5120; dst = (bf16_t*)(ws + W_C); gain = P.mix_gain + 1024; break;
            default: src = P.c_w_out; ld = 1024; coff = 0; K = 1024; N = 1024; dst = (bf16_t*)(ws + W_O0 + 2 * MiB); gain = nullptr; break;
        }
        const int nkt = K >> 6, nnt = N >> 6, ntile = nkt * nnt;
        const int kr = tid >> 3, c8 = (tid & 7) * 8;
        f32x4 ra, rb; float rgn = 1.f;
        if (bx < ntile) { const int kt = bx % nkt, nt = bx / nkt; const float* sp = src + (size_t)(kt * 64 + kr) * ld + coff + nt * 64 + c8; ra = *(const f32x4*)sp; rb = *(const f32x4*)(sp + 4); rgn = gain ? gain[kt * 64 + kr] : 1.0f; }
        for (int ti = bx; ti < ntile; ti += G) {
            const int kt = ti % nkt, nt = ti / nkt, k0 = kt * 64, n0 = nt * 64;
            { float* tp = tile + kr * 65 + c8;
              tp[0] = ra[0] * rgn; tp[1] = ra[1] * rgn; tp[2] = ra[2] * rgn; tp[3] = ra[3] * rgn; tp[4] = rb[0] * rgn; tp[5] = rb[1] * rgn; tp[6] = rb[2] * rgn; tp[7] = rb[3] * rgn; }
            __syncthreads();
            if (ti + G < ntile) {
                const int t2 = ti + G, kt2 = t2 % nkt, nt2 = t2 / nkt; const float* sp = src + (size_t)(kt2 * 64 + kr) * ld + coff + nt2 * 64 + c8;
                ra = *(const f32x4*)sp; rb = *(const f32x4*)(sp + 4); rgn = gain ? gain[kt2 * 64 + kr] : 1.0f; }
            { const int nr = tid >> 3, k8 = (tid & 7) * 8;
              const float* tp = tile + k8 * 65 + nr;
              u32x4 w; w.x = pk2(tp[0], tp[65]); w.y = pk2(tp[130], tp[195]); w.z = pk2(tp[260], tp[325]); w.w = pk2(tp[390], tp[455]);
              __builtin_nontemporal_store(w, (u32x4*)(dst + (size_t)(n0 + nr) * K + k0 + k8)); }
            __syncthreads();
        }
    }
}

__device__ __forceinline__ void p0_prologue(const Params& P, unsigned char* lds) {
    const int tid = otid(), lane = tid & 63, wid = tid >> 6;
    const int G = gridDim.x, bx = blockIdx.x;
    unsigned char* ws = P.ws;
    float* tile = (float*)lds;
    float* twc = (float*)(lds + 64 * 65 * 4);
    float* tws = twc + 64;
    if (tid < 64) { twc[tid] = __builtin_amdgcn_cosf((float)tid * (1.0f / 64.0f)); tws[tid] = __builtin_amdgcn_sinf((float)tid * (1.0f / 64.0f)); }
    __syncthreads();
    weight_jobs(P, lds, 0, 1, bx, G);
    {
        const float scale = 0.0019493177f;
        bf16_t* dst = (bf16_t*)(ws + W_UCS);
        for (int ti = bx; ti < 64; ti += G) {
            const int kt = ti & 15, g = ti >> 4, k0 = kt * 64;
            { const int kr = tid >> 3, c8 = (tid & 7) * 8;
              const float* sp = P.ab_w_in + (size_t)(k0 + kr) * 1536 + g * 64 + c8;
              const f32x4 a = *(const f32x4*)sp, b = *(const f32x4*)(sp + 4);
              const float gn = P.mix_gain[k0 + kr] * scale;
              float* tp = tile + kr * 65 + c8;
              tp[0] = a[0] * gn; tp[1] = a[1] * gn; tp[2] = a[2] * gn; tp[3] = a[3] * gn; tp[4] = b[0] * gn; tp[5] = b[1] * gn; tp[6] = b[2] * gn; tp[7] = b[3] * gn; }
            __syncthreads();
            { const int cp = tid >> 3, k8 = (tid & 7) * 8;
              float ac[8], as[8];
#pragma unroll
              for (int j = 0; j < 8; ++j) { ac[j] = 0.f; as[j] = 0.f; }
              for (int c = 0; c < 64; ++c) {
                  const int mm = (c * cp) & 63; const float cw = twc[mm], sw = tws[mm];
#pragma unroll
                  for (int j = 0; j < 8; ++j) { const float v = tile[(k8 + j) * 65 + c]; ac[j] += v * cw; as[j] += v * sw; }
              }
              u32x4 w; w.x = pk2(ac[0], ac[1]); w.y = pk2(ac[2], ac[3]); w.z = pk2(ac[4], ac[5]); w.w = pk2(ac[6], ac[7]);
              *(u32x4*)(dst + (size_t)(g * 64 + cp) * DM + k0 + k8) = w;
              w.x = pk2(as[0], as[1]); w.y = pk2(as[2], as[3]); w.z = pk2(as[4], as[5]); w.w = pk2(as[6], as[7]);
              *(u32x4*)(dst + (size_t)(256 + g * 64 + cp) * DM + k0 + k8) = w; }
            __syncthreads();
        }
    }
    {
        float* rowss = (float*)(ws + WS_ROWSS); bf16_t* HB = (bf16_t*)(ws + WS_HB); bf16_t* Y = (bf16_t*)(ws + WS_Y);
        const int nw = G * 8;
        for (int row0 = bx * 8 + wid; row0 < TP; row0 += 2 * nw) {
            f32x4 v[2][4];
#pragma unroll
            for (int r = 0; r < 2; ++r) { const int row = row0 + r * nw;
                if (row < T) { const float* src = (row < NREAL ? P.x + (size_t)row * DM : P.meta + (size_t)((row - NREAL) & 15) * DM) + lane * 16;
#pragma unroll
                    for (int i = 0; i < 4; ++i) v[r][i] = __builtin_nontemporal_load((const f32x4*)(src + 4 * i)); }
                else {
#pragma unroll
                    for (int i = 0; i < 4; ++i) v[r][i] = (f32x4){0.f, 0.f, 0.f, 0.f}; } }
#pragma unroll
            for (int r = 0; r < 2; ++r) { const int row = row0 + r * nw;
                if (row < TP) {
                    float ss = 0.f;
#pragma unroll
                    for (int i = 0; i < 4; ++i) ss += (v[r][i][0] * v[r][i][0] + v[r][i][1] * v[r][i][1]) + (v[r][i][2] * v[r][i][2] + v[r][i][3] * v[r][i][3]);
                    u32x4 w0, w1;
                    w0.x = pk2(v[r][0][0], v[r][0][1]); w0.y = pk2(v[r][0][2], v[r][0][3]); w0.z = pk2(v[r][1][0], v[r][1][1]); w0.w = pk2(v[r][1][2], v[r][1][3]);
                    w1.x = pk2(v[r][2][0], v[r][2][1]); w1.y = pk2(v[r][2][2], v[r][2][3]); w1.z = pk2(v[r][3][0], v[r][3][1]); w1.w = pk2(v[r][3][2], v[r][3][3]);
                    *(u32x4*)(HB + (size_t)row * DM + lane * 16) = w0; *(u32x4*)(HB + (size_t)row * DM + lane * 16 + 8) = w1;
                    if (row >= T) { const u32x4 z = {0u, 0u, 0u, 0u}; *(u32x4*)(Y + (size_t)row * DM + lane * 16) = z; *(u32x4*)(Y + (size_t)row * DM + lane * 16 + 8) = z; }
                    ss = wave_sum(ss);
                    if (lane == 0) rowss[row] = ss;
                    if (lane >= 1 && lane < 5) rowss[(size_t)lane * TP + row] = 0.f;
                }
            }
        }
    }
    const long gtid = (long)bx * 512 + tid, gthreads = (long)G * 512;
    if (gtid < 2048) {
        const int dir = (int)gtid >> 10, c = (int)gtid & 1023;
        const float l0 = P.c_lb[dir * 1024 + c], l1 = P.c_lb[2048 + dir * 1024 + c];
        ((float*)(ws + WS_LB))[gtid] = 1.0f / (1.0f + __expf(l0 - l1));
    }
    {
        bf16_t* U = (bf16_t*)(ws + WS_UCST);
        for (long i = gtid; i < 2048 * 12; i += gthreads) {
            const int row = (int)(i / 12), k = (int)(i % 12), seg = k / 6, e = k % 6;
            const u32x4 z = {0u, 0u, 0u, 0u};
            *(u32x4*)(U + (size_t)row * KF + seg * LK + LT + e * 8) = z;
        }
    }
}

__device__ __forceinline__ void qk_norm_rope(const Params& P, int dry = 0) {
    const int tid = otid(), lane = tid & 63, wid = tid >> 6;
    bf16_t* ZQ = (bf16_t*)(P.ws + WS_ZQ);
    const int head = lane >> 3, d0 = (lane & 7) * 8;
    const float* gain = head < 6 ? P.ab_q_gain : P.ab_k_gain;
    float inv[8], g1[8], g2[8];
#pragma unroll
    for (int e = 0; e < 8; ++e) { inv[e] = __builtin_amdgcn_exp2f(-(float)((d0 + e) & 31) * (13.287712379549449f / 32.0f)); g1[e] = gain[d0 + e]; g2[e] = gain[64 + d0 + e]; }
    const int nw = gridDim.x * 8, w0 = blockIdx.x * 8 + wid;
    for (int row = w0; row < T; row += 2 * nw) {
        const int rowb = row + nw; const bool hasb = rowb < T;
        bf16_t* za = ZQ + (size_t)row * NQKV + head * 128 + d0; bf16_t* zb = ZQ + (size_t)(hasb ? rowb : row) * NQKV + head * 128 + d0;
        const u32x4 a1 = *(const u32x4*)za, a2 = *(const u32x4*)(za + 64), b1 = *(const u32x4*)zb, b2 = *(const u32x4*)(zb + 64);
#pragma unroll
        for (int it = 0; it < 2; ++it) {
            const u32x4 w1 = it ? b1 : a1, w2 = it ? b2 : a2; const int r = it ? rowb : row; bf16_t* zp = it ? zb : za;
            float x1[8], x2[8];
            x1[0] = blo(w1.x); x1[1] = bhi(w1.x); x1[2] = blo(w1.y); x1[3] = bhi(w1.y); x1[4] = blo(w1.z); x1[5] = bhi(w1.z); x1[6] = blo(w1.w); x1[7] = bhi(w1.w);
            x2[0] = blo(w2.x); x2[1] = bhi(w2.x); x2[2] = blo(w2.y); x2[3] = bhi(w2.y); x2[4] = blo(w2.z); x2[5] = bhi(w2.z); x2[6] = blo(w2.w); x2[7] = bhi(w2.w);
            float ss = 0.f;
#pragma unroll
            for (int e = 0; e < 8; ++e) ss += x1[e] * x1[e] + x2[e] * x2[e];
            ss += __shfl_xor(ss, 1); ss += __shfl_xor(ss, 2); ss += __shfl_xor(ss, 4);
            const float rs = rsqrtf(ss * (1.0f / 128.0f) + EPS);
            float o1[8], o2[8];
            const bool real = r < NREAL; const int pos = r & 4095; const float pv = (float)((lane & 7) < 4 ? (pos >> 6) : (pos & 63));
#pragma unroll
            for (int e = 0; e < 8; ++e) {
                const float y1 = x1[e] * rs * g1[e], y2 = x2[e] * rs * g2[e];
                float rev = pv * inv[e] * 0.15915494309189535f; rev -= floorf(rev);
                const float c = real ? __builtin_amdgcn_cosf(rev) : 1.f, sn = real ? __builtin_amdgcn_sinf(rev) : 0.f;
                o1[e] = y1 * c - y2 * sn; o2[e] = y2 * c + y1 * sn;
            }
            if (!dry && (it == 0 || hasb)) {
                u32x4 v1, v2;
                v1.x = pk2(o1[0], o1[1]); v1.y = pk2(o1[2], o1[3]); v1.z = pk2(o1[4], o1[5]); v1.w = pk2(o1[6], o1[7]);
                v2.x = pk2(o2[0], o2[1]); v2.y = pk2(o2[2], o2[3]); v2.z = pk2(o2[4], o2[5]); v2.w = pk2(o2[6], o2[7]);
                *(u32x4*)zp = v1; *(u32x4*)(zp + 64) = v2;
            }
        }
    }
}

namespace att {
constexpr int QBLK = 32, KVBLK = 64, NW = 8;
constexpr float SCALE = 0.088388347648318440f;
constexpr float THR = 8.f;
constexpr size_t SHM_V = KVBLK * 128 * 2, SHM_K = KVBLK * 128 * 2, SHM_ATTN = 2 * SHM_V + 2 * SHM_K + NW * 64 * 4;
constexpr int NT = 66;
#define KSWZ(row, colB) ((row) * 256 + ((colB) ^ (((row) & 7) << 4)))
#define SBAR() __builtin_amdgcn_sched_barrier(0)
__device__ __forceinline__ void partialSM(f32x16& p0, f32x16& p1, float& m_reg, float& mn, float& alpha) {
  constexpr float C = SCALE * 1.4426950408889634f;
  float pmax = p0[0]; for (int r = 1; r < 16; ++r) pmax = fmaxf(pmax, p0[r]); for (int r = 0; r < 16; ++r) pmax = fmaxf(pmax, p1[r]);
  { auto rr = __builtin_amdgcn_permlane32_swap(__float_as_uint(pmax), __float_as_uint(pmax), false, false);
    pmax = fmaxf(__uint_as_float(rr[0]), __uint_as_float(rr[1])); }
  if (__builtin_expect(__all(pmax - m_reg <= THR / SCALE), 1)) { mn = m_reg; alpha = 1.f; }
  else { mn = fmaxf(m_reg, pmax); alpha = __builtin_amdgcn_exp2f((m_reg - mn) * C); m_reg = mn; }
  float mnC = -mn * C;
  for (int r = 0; r < 16; ++r) p0[r] = fmaf(p0[r], C, mnC); for (int r = 0; r < 16; ++r) p1[r] = fmaf(p1[r], C, mnC);
  for (int r = 0; r < 16; ++r) p0[r] = __builtin_amdgcn_exp2f(p0[r]);
}
__device__ __forceinline__ void finishSM(f32x16& p0, f32x16& p1, float alpha, float& l_reg, bf16x8& pa0, bf16x8& pa1, bf16x8& pa2, bf16x8& pa3) {
  for (int r = 0; r < 16; ++r) p1[r] = __builtin_amdgcn_exp2f(p1[r]);
  float ps = 0; for (int r = 0; r < 16; ++r) ps += p0[r]; for (int r = 0; r < 16; ++r) ps += p1[r];
  { auto rr = __builtin_amdgcn_permlane32_swap(__float_as_uint(ps), __float_as_uint(ps), false, false);
    ps = __uint_as_float(rr[0]) + __uint_as_float(rr[1]); }
  l_reg = l_reg * alpha + ps;
#define PK4(P, BASE, OUT) do { unsigned a0 = pk2(P[BASE + 0], P[BASE + 1]), a1 = pk2(P[BASE + 2], P[BASE + 3]);   \
    unsigned b0 = pk2(P[BASE + 4], P[BASE + 5]), b1 = pk2(P[BASE + 6], P[BASE + 7]);                              \
    auto r0 = __builtin_amdgcn_permlane32_swap(a0, b0, false, false); auto r1 = __builtin_amdgcn_permlane32_swap(a1, b1, false, false); \
    u32x4 w = {r0[0], r1[0], r0[1], r1[1]}; OUT = *reinterpret_cast<bf16x8*>(&w); } while (0)
  PK4(p0, 0, pa0); PK4(p0, 8, pa1); PK4(p1, 0, pa2); PK4(p1, 8, pa3);
#undef PK4
}
__device__ __forceinline__ void qkt(f32x16& p0, f32x16& p1, const bf16_t* Ks, const bf16x8* qr, int r32, int hi) {
  p0 = f32x16{}; p1 = f32x16{};
  for (int d0 = 0; d0 < 8; ++d0) { int cb = (d0 * 16 + hi * 8) * 2;
    bf16x8 b0 = *reinterpret_cast<const bf16x8*>((const char*)Ks + KSWZ(r32, cb));
    bf16x8 b1 = *reinterpret_cast<const bf16x8*>((const char*)Ks + KSWZ(32 + r32, cb));
    p0 = mfma32(b0, qr[d0], p0);
    p1 = mfma32(b1, qr[d0], p1); }
}
__device__ __forceinline__ void kmask(f32x16& p0, f32x16& p1, int tile, int hi) {
  if (tile >= 64) {
    const int lim = tile == 64 ? 16 : 0;
#pragma unroll
    for (int r = 0; r < 16; ++r) { if (crow(r, hi) >= lim) p0[r] = -1e30f; p1[r] = -1e30f; }
  }
}
__device__ __forceinline__ int v_st(int k, int c) { const int kk = (k & ~0xC) | ((k & 4) << 1) | ((k & 8) >> 1); return ((kk >> 3) * 4 + (c >> 5)) * 512 + ((kk & 7) * 32 + (c & 31)) * 2; }
__device__ __forceinline__ int v_rd_base(int lane) { return ((lane & 3) << 3) | (((lane >> 2) & 3) << 6) | (((lane >> 4) & 1) << 5) | (((lane >> 5) & 1) << 8); }
constexpr int v_rd_off(int d0, int ks, int half) { return d0 * 512 + ks * 4096 + half * 2048; }
template <int OFF> __device__ __forceinline__ s16x4 tr_read(int vb) {
  s16x4 r; asm volatile("ds_read_b64_tr_b16 %0, %1 offset:%2" : "=&v"(r) : "v"(vb), "i"(OFF) : "memory"); return r;
}
template <int D0> __device__ __forceinline__ void pv_one(f32x16& od, int vb, bf16x8 pa0, bf16x8 pa1, bf16x8 pa2, bf16x8 pa3) {
  const s16x4 l0 = tr_read<v_rd_off(D0, 0, 0)>(vb), h0 = tr_read<v_rd_off(D0, 0, 1)>(vb), l1 = tr_read<v_rd_off(D0, 1, 0)>(vb), h1 = tr_read<v_rd_off(D0, 1, 1)>(vb);
  const s16x4 l2 = tr_read<v_rd_off(D0, 2, 0)>(vb), h2 = tr_read<v_rd_off(D0, 2, 1)>(vb), l3 = tr_read<v_rd_off(D0, 3, 0)>(vb), h3 = tr_read<v_rd_off(D0, 3, 1)>(vb);
  asm volatile("s_waitcnt lgkmcnt(0)" ::: "memory"); SBAR();
#define PK(L, H) (bf16x8){L[0], L[1], L[2], L[3], H[0], H[1], H[2], H[3]}
  od = mfma32(pa0, PK(l0, h0), od);
  od = mfma32(pa1, PK(l1, h1), od);
  od = mfma32(pa2, PK(l2, h2), od);
  od = mfma32(pa3, PK(l3, h3), od);
#undef PK
}
__device__ __forceinline__ void pv_d0(f32x16* o, int vb, bf16x8 pa0, bf16x8 pa1, bf16x8 pa2, bf16x8 pa3) {
  pv_one<0>(o[0], vb, pa0, pa1, pa2, pa3); pv_one<1>(o[1], vb, pa0, pa1, pa2, pa3); pv_one<2>(o[2], vb, pa0, pa1, pa2, pa3); pv_one<3>(o[3], vb, pa0, pa1, pa2, pa3);
}
__device__ __forceinline__ void attn_unit(const bf16_t* __restrict__ ZQ, bf16_t* __restrict__ Y, int b, int hsel, int qb, char* lds) {
  const int tid = otid(), wid = tid >> 6, lane = tid & 63, r32 = lane & 31, hi = lane >> 5;
  bf16_t* V_lds = (bf16_t*)lds; bf16_t* K_lds = (bf16_t*)(lds + 2 * SHM_V);
  float* ws = (float*)(lds + 2 * SHM_V + 2 * SHM_K) + wid * 64; float* li_l = ws; float* al_l = ws + 32;
  float m_reg = -1e30f, l_reg = 0; f32x16 o[4] = {}; bf16x8 qr[8];
  const bool meta = qb >= 16;
  const int h = meta ? hsel * 3 + (wid < 3 ? wid : 2) : hsel; const int kvh = meta ? hsel : hsel / 3;
  const long tb_real = (long)b * SEQ, tb_meta = (long)NREAL + 16 * b;
  { const long qrow = meta ? tb_meta + (r32 & 15) : tb_real + qb * 256 + wid * QBLK + r32;
    const bf16_t* Qw = ZQ + qrow * NQKV + h * 128 + hi * 8;
#pragma unroll
    for (int d0 = 0; d0 < 8; ++d0) qr[d0] = *reinterpret_cast<const bf16x8*>(Qw + d0 * 16); }
  const bf16_t* Kh = ZQ + 768 + kvh * 128; const bf16_t* Vh = ZQ + 1024 + kvh * 128;
  constexpr int LDK = NQKV;
  const int sr = tid >> 4, sc = (tid & 15) * 8, vst0 = v_st(sr, sc), vst1 = v_st(32 + sr, sc);
  const int vb0 = (int)(uintptr_t)V_lds + v_rd_base(lane);
  struct { bf16x8 vs0, vs1, ks0, ks1; } sr_[1];
#define SLOAD(i, t) do { const long k0_ = ((t) < 64 ? tb_real + 64 * (t) : tb_meta); sr_[i].vs0 = *reinterpret_cast<const bf16x8*>(&Vh[(k0_ + sr) * LDK + sc]); sr_[i].vs1 = *reinterpret_cast<const bf16x8*>(&Vh[(k0_ + 32 + sr) * LDK + sc]); \
    sr_[i].ks0 = *reinterpret_cast<const bf16x8*>(&Kh[(k0_ + sr) * LDK + sc]); sr_[i].ks1 = *reinterpret_cast<const bf16x8*>(&Kh[(k0_ + 32 + sr) * LDK + sc]); } while (0)
#define SWRITE(bb, i) do { *(bf16x8*)((char*)V_lds + (bb) * SHM_V + vst0) = sr_[i].vs0;          \
    *(bf16x8*)((char*)V_lds + (bb) * SHM_V + vst1) = sr_[i].vs1; int kc = sc * 2;               \
    *(bf16x8*)((char*)K_lds + (bb) * SHM_K + KSWZ(sr, kc)) = sr_[i].ks0;                       \
    *(bf16x8*)((char*)K_lds + (bb) * SHM_K + KSWZ(32 + sr, kc)) = sr_[i].ks1; } while (0)
#define SWAIT() asm volatile("s_waitcnt vmcnt(0)" ::: "memory")
#define RESC(a) do { if (__any((a) < 1.f)) { if (hi == 0) al_l[r32] = (a); asm volatile("s_waitcnt lgkmcnt(0)" ::: "memory"); \
    for (int d = 0; d < 4; ++d) for (int r = 0; r < 16; ++r) o[d][r] *= al_l[crow(r, hi)]; } } while (0)
  f32x16 pA0, pA1, pB0, pB1; float mnA, mnB, alA, alB; bf16x8 pa0, pa1, pa2, pa3;
  constexpr int SE = 0, SO = 0;
  SLOAD(SE, 0); asm volatile("s_waitcnt vmcnt(0)" ::: "memory"); SWRITE(0, SE); __syncthreads();
  qkt(pA0, pA1, K_lds, qr, r32, hi); partialSM(pA0, pA1, m_reg, mnA, alA);
  SLOAD(SO, 1);
  SWAIT(); SWRITE(1, SO); __syncthreads();
  for (int j = 1; j + 1 < NT; j += 2) {
    SBAR(); qkt(pB0, pB1, (bf16_t*)((char*)K_lds + SHM_K), qr, r32, hi); kmask(pB0, pB1, j, hi);
    finishSM(pA0, pA1, alA, l_reg, pa0, pa1, pa2, pa3); SBAR();
    SLOAD(SO, j + 1); SBAR();
    pv_d0(o, vb0, pa0, pa1, pa2, pa3); partialSM(pB0, pB1, m_reg, mnB, alB);
    __syncthreads(); SWAIT(); SWRITE(0, SE);
    RESC(alB); __syncthreads();
    SBAR(); qkt(pA0, pA1, K_lds, qr, r32, hi); kmask(pA0, pA1, j + 1, hi);
    finishSM(pB0, pB1, alB, l_reg, pa0, pa1, pa2, pa3); SBAR();
    SLOAD(SE, j + 2); SBAR();
    pv_d0(o, vb0 + (int)SHM_V, pa0, pa1, pa2, pa3); partialSM(pA0, pA1, m_reg, mnA, alA);
    __syncthreads(); SWAIT(); SWRITE(1, SO);
    RESC(alA); __syncthreads();
  }
  SBAR(); finishSM(pA0, pA1, alA, l_reg, pa0, pa1, pa2, pa3); SBAR();
  pv_d0(o, vb0, pa0, pa1, pa2, pa3);
  if (hi == 0) li_l[r32] = l_reg; asm volatile("s_waitcnt lgkmcnt(0)" ::: "memory");
  float rli[16];
#pragma unroll
  for (int r = 0; r < 16; ++r) rli[r] = __builtin_amdgcn_rcpf(li_l[crow(r, hi)]);
#pragma unroll
  for (int r = 0; r < 16; ++r) { const int ri = crow(r, hi);
    if (!meta || (wid < 3 && ri < 16)) { bf16_t* yp = Y + (meta ? tb_meta + ri : tb_real + qb * 256 + wid * QBLK + ri) * DM + 256 + h * 128 + r32;
#pragma unroll
      for (int d0 = 0; d0 < 4; ++d0) yp[d0 * 32] = f2b(o[d0][r] * rli[r]); } }
  __syncthreads();
#undef SLOAD
#undef SWRITE
#undef SWAIT
#undef RESC
}
}

#define LBAR() asm volatile("s_waitcnt lgkmcnt(0)\n\ts_barrier" ::: "memory")
__device__ __forceinline__ void scan_unit(const bf16_t* __restrict__ Z1, bf16_t* __restrict__ OUT, int b, int h, int dir, int vs, unsigned char* lds, int dry = 0) {
    const int tid = otid(), wid = tid >> 6, lane = tid & 63, r32 = lane & 31, hi = lane >> 5;
    float* TOT = (float*)(lds); float* DVv = (float*)(lds + 4096);
    bf16_t* QT = (bf16_t*)(lds + 4608); bf16_t* KT = (bf16_t*)(lds + 22016); bf16_t* QI = (bf16_t*)(lds + 39424); bf16_t* KHT = (bf16_t*)(lds + 56832);
    bf16_t* VT = (bf16_t*)(lds + 75264); bf16_t* AS = (bf16_t*)(lds + 84480); bf16_t* SB = (bf16_t*)(lds + 93696);
    const int cp = tid & 63, seg = __builtin_amdgcn_readfirstlane(tid >> 6);
    const int vp = tid & 31, tgv = tid >> 5;
    const bf16_t* Qg = Z1 + h * 128 + 2 * cp; const bf16_t* Gg = Z1 + 1024 + dir * 1024 + h * 128 + 2 * cp; const bf16_t* Vg = Z1 + 3072 + h * 128 + vs * 64 + 2 * vp;
    f32x16 Sacc = {}; f32x16 oacc = {};
    for (int i = tid; i < 17408 / 4; i += 512) ((unsigned*)SB)[i] = 0u;
    int cur = 0;
    unsigned rq[8], rk[8], rv[4];
#define LOADC(cc) do { const int c_ = (cc); const long tk_ = c_ ? (long)b * SEQ + 64 * (c_ - 1) : (long)NREAL + 16 * b; \
    if (c_ != 0 || seg < 2) { const bf16_t* qp_ = Qg + (size_t)(tk_ + 8 * seg) * NC; const bf16_t* gp_ = Gg + (size_t)(tk_ + 8 * seg) * NC; \
        _Pragma("unroll") for (int i_ = 0; i_ < 8; ++i_) { rq[i_] = *(const unsigned*)qp_; rk[i_] = *(const unsigned*)gp_; qp_ += NC; gp_ += NC; } } \
    else { _Pragma("unroll") for (int i_ = 0; i_ < 8; ++i_) { rq[i_] = 0u; rk[i_] = 0u; } } \
    if (c_ != 0 || tgv < 4) { const bf16_t* vp_ = Vg + (size_t)(tk_ + 4 * tgv) * NC; \
        _Pragma("unroll") for (int i_ = 0; i_ < 4; ++i_) { rv[i_] = *(const unsigned*)vp_; vp_ += NC; } } \
    else { _Pragma("unroll") for (int i_ = 0; i_ < 4; ++i_) rv[i_] = 0u; } } while (0)
    LOADC(dir ? 64 : 0);
#pragma nounroll
    for (int step = 0; step < 65; ++step) {
        const int c = dir ? 64 - step : step;
        const long tok0 = c ? (long)b * SEQ + 64 * (c - 1) : (long)NREAL + 16 * b; const int nvalid = c ? 64 : 16;
        float ka[8], kb[8], pa[8], pb[8];
#pragma unroll
        for (int i = 0; i < 8; ++i) { ka[i] = blo(rk[i]); kb[i] = bhi(rk[i]); }
        { float xa = 1.f, xb = 1.f;
          if (dir == 0) {
#pragma unroll
              for (int i = 0; i < 8; ++i) { xa *= 1.0f - ka[i]; xb *= 1.0f - kb[i]; pa[i] = xa; pb[i] = xb; } }
          else {
#pragma unroll
              for (int i = 7; i >= 0; --i) { xa *= 1.0f - ka[i]; xb *= 1.0f - kb[i]; pa[i] = xa; pb[i] = xb; } }
          *(f32x2*)(TOT + seg * 128 + 2 * cp) = (f32x2){xa, xb}; }
        LBAR();
        {
            f32x2 Ts[8];
#pragma unroll
            for (int s_ = 0; s_ < 8; ++s_) Ts[s_] = *(const f32x2*)(TOT + s_ * 128 + 2 * cp);
            const f32x2 lo4 = (Ts[0] * Ts[1]) * (Ts[2] * Ts[3]), hi4 = (Ts[4] * Ts[5]) * (Ts[6] * Ts[7]);
            const f32x2 one = {1.f, 1.f};
            f32x2 cs, eref, erest;
            if (dir == 0) {
                eref = lo4; erest = hi4;
                if (seg <= 3) { f32x2 m = one;
#pragma unroll
                    for (int s_ = 0; s_ < 4; ++s_) m = m * (s_ >= seg ? Ts[s_] : one);
                    cs.x = __builtin_amdgcn_rcpf(m.x); cs.y = __builtin_amdgcn_rcpf(m.y); }
                else { f32x2 m = one;
#pragma unroll
                    for (int s_ = 4; s_ < 7; ++s_) m = m * (s_ < seg ? Ts[s_] : one);
                    cs = m; }
            } else {
                eref = hi4; erest = lo4;
                if (seg >= 4) { f32x2 m = one;
#pragma unroll
                    for (int s_ = 4; s_ < 8; ++s_) m = m * (s_ <= seg ? Ts[s_] : one);
                    cs.x = __builtin_amdgcn_rcpf(m.x); cs.y = __builtin_amdgcn_rcpf(m.y); }
                else { f32x2 m = one;
#pragma unroll
                    for (int s_ = 1; s_ < 4; ++s_) m = m * (s_ > seg ? Ts[s_] : one);
                    cs = m; }
            }
            float kha[8], khb[8];
#pragma unroll
            for (int i = 0; i < 8; ++i) {
                const float Ra = pa[i] * cs.x, Rb = pb[i] * cs.y;
                const float qa = blo(rq[i]), qb_ = bhi(rq[i]);
                const float ia = __builtin_amdgcn_rcpf(Ra), ib = __builtin_amdgcn_rcpf(Rb);
                const float qra = qa * Ra, qrb = qb_ * Rb, kia = ka[i] * ia, kib = kb[i] * ib;
                const int o_ = (8 * seg + i) * 136 + 2 * cp;
                *(unsigned*)(QT + o_) = pk2_bf(qra, qrb);
                *(unsigned*)(QI + o_) = pk2(qra * eref.x, qrb * eref.y);
                *(unsigned*)(KT + o_) = pk2_bf(kia, kib);
                kha[i] = kia * erest.x; khb[i] = kib * erest.y;
            }
            u32x4 w0, w1;
            w0.x = pk2(kha[0], kha[1]); w0.y = pk2(kha[2], kha[3]); w0.z = pk2(kha[4], kha[5]); w0.w = pk2(kha[6], kha[7]);
            w1.x = pk2(khb[0], khb[1]); w1.y = pk2(khb[2], khb[3]); w1.z = pk2(khb[4], khb[5]); w1.w = pk2(khb[6], khb[7]);
            *(u32x4*)(KHT + (2 * cp) * 72 + 8 * seg) = w0; *(u32x4*)(KHT + (2 * cp + 1) * 72 + 8 * seg) = w1;
            if (seg == 0) *(f32x2*)(DVv + 2 * cp) = lo4 * hi4;
            u32x2 va, vb;
            va.x = (rv[0] & 0xffffu) | (rv[1] << 16); va.y = (rv[2] & 0xffffu) | (rv[3] << 16);
            vb.x = (rv[0] >> 16) | (rv[1] & 0xffff0000u); vb.y = (rv[2] >> 16) | (rv[3] & 0xffff0000u);
            *(u32x2*)(VT + (2 * vp) * 72 + 4 * tgv) = va; *(u32x2*)(VT + (2 * vp + 1) * 72 + 4 * tgv) = vb;
        }
        if (step + 1 < 65 && !(dry & 2)) LOADC(dir ? 63 - step : step + 1);
        LBAR();
        if (wid < 4) {
            const int a = wid >> 1, sb = wid & 1;
            f32x16 p = {};
            const bf16_t* kp = KT + (32 * sb + r32) * 136 + 8 * hi; const bf16_t* qp = QT + (32 * a + r32) * 136 + 8 * hi;
#pragma unroll
            for (int kk = 0; kk < 8; ++kk) p = __builtin_amdgcn_mfma_f32_32x32x16_bf16(*(const bf16x8*)(kp + 16 * kk), *(const bf16x8*)(qp + 16 * kk), p, 0, 0, 0);
            const int t = 32 * a + r32;
#pragma unroll
            for (int r4 = 0; r4 < 4; ++r4) {
                const int s0 = 32 * sb + 8 * r4 + 4 * hi; float v[4];
#pragma unroll
                for (int e = 0; e < 4; ++e) { const int s_ = s0 + e; const bool keep = dir == 0 ? (s_ <= t) : (s_ >= t); v[e] = keep ? p[4 * r4 + e] : 0.f; }
                u32x2 w; w.x = pk2(v[0], v[1]); w.y = pk2(v[2], v[3]);
                *(u32x2*)(AS + t * 72 + s0) = w;
            }
        } else {
            const int a = (wid - 4) >> 1, j = (wid - 4) & 1;
            oacc = f32x16{};
            const bf16_t* qp = QI + (32 * a + r32) * 136 + 8 * hi; const bf16_t* sp = SB + cur * 8704 + (32 * j + r32) * 136 + 8 * hi;
#pragma unroll
            for (int kk = 0; kk < 8; ++kk) oacc = mfma32(*(const bf16x8*)(qp + 16 * kk), *(const bf16x8*)(sp + 16 * kk), oacc);
        }
        {
            const int i = wid >> 1, j = wid & 1;
#pragma unroll
            for (int r = 0; r < 16; ++r) Sacc[r] *= DVv[32 * i + crow(r, hi)];
            const bf16_t* ap = KHT + (32 * i + r32) * 72 + 8 * hi; const bf16_t* vp = VT + (32 * j + r32) * 72 + 8 * hi;
#pragma unroll
            for (int kk = 0; kk < 4; ++kk) Sacc = mfma32(*(const bf16x8*)(ap + 16 * kk), *(const bf16x8*)(vp + 16 * kk), Sacc);
            bf16_t* sbn = SB + (cur ^ 1) * 8704 + (32 * j + r32) * 136 + 32 * i + 4 * hi;
#pragma unroll
            for (int r4 = 0; r4 < 4; ++r4) { u32x2 w; w.x = pk2(Sacc[4 * r4], Sacc[4 * r4 + 1]); w.y = pk2(Sacc[4 * r4 + 2], Sacc[4 * r4 + 3]); *(u32x2*)(sbn + 8 * r4) = w; }
        }
        LBAR();
        if (wid >= 4) {
            const int a = (wid - 4) >> 1, j = (wid - 4) & 1;
            const bf16_t* ap = AS + (32 * a + r32) * 72 + 8 * hi; const bf16_t* vp = VT + (32 * j + r32) * 72 + 8 * hi;
#pragma unroll
            for (int kk = 0; kk < 4; ++kk) oacc = mfma32(*(const bf16x8*)(ap + 16 * kk), *(const bf16x8*)(vp + 16 * kk), oacc);
            bf16_t* ost = QT + (wid - 4) * 1280;
#pragma unroll
            for (int r = 0; r < 16; ++r) ost[crow(r, hi) * 40 + r32] = f2b(oacc[r]);
            asm volatile("s_waitcnt lgkmcnt(0)" ::: "memory");
#pragma unroll
            for (int i = 0; i < 2; ++i) {
                const int pc = lane + 64 * i, row = pc >> 2, sg = pc & 3;
                const u32x4 w = *(const u32x4*)(ost + row * 40 + sg * 8);
                if (32 * a + row < nvalid && !(dry & 1)) *(u32x4*)(OUT + (size_t)(tok0 + 32 * a + row) * DM + h * 128 + vs * 64 + 32 * j + sg * 8) = w;
            }
        }
        cur ^= 1;
    }
    __syncthreads();
#undef LOADC
}

__device__ __forceinline__ void hgrn_finalize(const Params& P, int dry = 0) {
    const int tid = otid(), lane = tid & 63, wid = tid >> 6;
    const bf16_t* O = (const bf16_t*)P.out; const bf16_t* Z1 = (const bf16_t*)(P.ws + WS_Z1); bf16_t* Y = (bf16_t*)(P.ws + WS_Y);
    const int col = (lane >> 3) * 128 + (lane & 7) * 16;
    float og[16];
#pragma unroll
    for (int e = 0; e < 16; ++e) og[e] = P.c_o_gain[col + e];
    const int nw = gridDim.x * 8, w0 = blockIdx.x * 8 + wid;
    for (int row = w0; row < T; row += 2 * nw) {
        const int rowb = row + nw; const bool hasb = rowb < T; const int rb = hasb ? rowb : row;
        u32x4 oa[2], ya[2], ga[2], ob[2], yb[2], gb[2];
#pragma unroll
        for (int i = 0; i < 2; ++i) {
            oa[i] = *(const u32x4*)(O + (size_t)row * DM + col + 8 * i); ya[i] = *(const u32x4*)(Y + (size_t)row * DM + col + 8 * i); ga[i] = *(const u32x4*)(Z1 + (size_t)row * NC + 4096 + col + 8 * i);
            ob[i] = *(const u32x4*)(O + (size_t)rb * DM + col + 8 * i); yb[i] = *(const u32x4*)(Y + (size_t)rb * DM + col + 8 * i); gb[i] = *(const u32x4*)(Z1 + (size_t)rb * NC + 4096 + col + 8 * i);
        }
#pragma unroll
        for (int it = 0; it < 2; ++it) {
            float o[16], g[16];
#pragma unroll
            for (int i = 0; i < 2; ++i) {
                const u32x4 ow = it ? ob[i] : oa[i], yw = it ? yb[i] : ya[i], gw = it ? gb[i] : ga[i];
                o[8 * i + 0] = blo(ow.x) + blo(yw.x); o[8 * i + 1] = bhi(ow.x) + bhi(yw.x); o[8 * i + 2] = blo(ow.y) + blo(yw.y); o[8 * i + 3] = bhi(ow.y) + bhi(yw.y);
                o[8 * i + 4] = blo(ow.z) + blo(yw.z); o[8 * i + 5] = bhi(ow.z) + bhi(yw.z); o[8 * i + 6] = blo(ow.w) + blo(yw.w); o[8 * i + 7] = bhi(ow.w) + bhi(yw.w);
                g[8 * i + 0] = blo(gw.x); g[8 * i + 1] = bhi(gw.x); g[8 * i + 2] = blo(gw.y); g[8 * i + 3] = bhi(gw.y); g[8 * i + 4] = blo(gw.z); g[8 * i + 5] = bhi(gw.z); g[8 * i + 6] = blo(gw.w); g[8 * i + 7] = bhi(gw.w);
            }
            float ss = 0.f;
#pragma unroll
            for (int e = 0; e < 16; ++e) ss += o[e] * o[e];
            ss += __shfl_xor(ss, 1); ss += __shfl_xor(ss, 2); ss += __shfl_xor(ss, 4);
            const float rs = rsqrtf(ss * (1.0f / 128.0f) + EPS);
            if (!dry && (it == 0 || hasb)) {
                bf16_t* yp = Y + (size_t)(it ? rb : row) * DM + col;
#pragma unroll
                for (int i = 0; i < 2; ++i) {
                    u32x4 w;
                    w.x = pk2(o[8 * i + 0] * rs * og[8 * i + 0] * g[8 * i + 0], o[8 * i + 1] * rs * og[8 * i + 1] * g[8 * i + 1]);
                    w.y = pk2(o[8 * i + 2] * rs * og[8 * i + 2] * g[8 * i + 2], o[8 * i + 3] * rs * og[8 * i + 3] * g[8 * i + 3]);
                    w.z = pk2(o[8 * i + 4] * rs * og[8 * i + 4] * g[8 * i + 4], o[8 * i + 5] * rs * og[8 * i + 5] * g[8 * i + 5]);
                    w.w = pk2(o[8 * i + 6] * rs * og[8 * i + 6] * g[8 * i + 6], o[8 * i + 7] * rs * og[8 * i + 7] * g[8 * i + 7]);
                    *(u32x4*)(yp + 8 * i) = w;
                }
            }
        }
    }
}

__device__ __forceinline__ void fast_barrier(unsigned* bar, unsigned gen) {
    asm volatile("s_waitcnt vmcnt(0) lgkmcnt(0)" ::: "memory");
    __syncthreads();
    if (threadIdx.x == 0) {
        const unsigned g = blockIdx.x >> 5, ng = (gridDim.x + 31) >> 5;
        const unsigned gsz = (g + 1) * 32 <= gridDim.x ? 32u : gridDim.x - g * 32;
        __builtin_amdgcn_fence(__ATOMIC_RELEASE, "agent");
        asm volatile("s_waitcnt vmcnt(0)" ::: "memory");
        if (__hip_atomic_fetch_add(bar + 64 * g, 1u, __ATOMIC_RELAXED, __HIP_MEMORY_SCOPE_AGENT) + 1u == gsz * gen) {
            if (__hip_atomic_fetch_add(bar + 512, 1u, __ATOMIC_RELAXED, __HIP_MEMORY_SCOPE_AGENT) + 1u == ng * gen) {
                for (unsigned i = 0; i < ng; ++i) __hip_atomic_store(bar + 1024 + 64 * i, gen, __ATOMIC_RELAXED, __HIP_MEMORY_SCOPE_AGENT);
            }
        }
        while (__hip_atomic_load(bar + 1024 + 64 * g, __ATOMIC_RELAXED, __HIP_MEMORY_SCOPE_AGENT) < gen) __builtin_amdgcn_s_sleep(1);
        __builtin_amdgcn_fence(__ATOMIC_ACQUIRE, "agent");
        asm volatile("s_waitcnt vmcnt(0)" ::: "memory");
    }
    __syncthreads();
}
#ifdef REP_SYNC
#define GSYNC() do { ++nbar; fast_barrier(barw, nbar); ++nbar; fast_barrier(barw, nbar); } while (0)
#else
#define GSYNC() do { ++nbar; fast_barrier(barw, nbar); } while (0)
#endif
__global__ void __launch_bounds__(512) fwd_megakernel(Params P) {
    extern __shared__ __attribute__((aligned(16))) unsigned char lds[];
    cg::grid_group grid = cg::this_grid();
    PG8_LAS unsigned char* lds3 = (PG8_LAS unsigned char*)lds;
    unsigned char* ws = P.ws;
    const int G = gridDim.x, bx = blockIdx.x;
    float* rowss = (float*)(ws + WS_ROWSS);
    bf16_t* HB = (bf16_t*)(ws + WS_HB); bf16_t* Y = (bf16_t*)(ws + WS_Y);
    unsigned* barw = (unsigned*)(ws + WS_BAR); unsigned nbar = 0;

#ifndef REP_P0
#define REP_P0 1
#endif
#ifndef REP_ATTN
#define REP_ATTN 1
#endif
#ifndef REP_SCAN
#define REP_SCAN 1
#endif
#ifndef REP_FOUR
#define REP_FOUR 1
#endif
#ifndef REP_UP
#define REP_UP 1
#endif
#ifndef REP_META
#define REP_META 1
#endif
#ifndef REP_IN
#define REP_IN 1
#endif
#ifndef REP_HG
#define REP_HG 1
#endif
#ifndef SCAN_DRY
#define SCAN_DRY 0
#endif
#pragma nounroll
    for (int rep = 0; rep < REP_P0; ++rep) { p0_prologue(P, lds); if (rep + 1 < REP_P0) GSYNC(); }
    asm volatile("s_waitcnt vmcnt(0)" ::: "memory"); grid.sync();

#pragma nounroll
    for (int layer = 0; layer < 2; ++layer) {
        if (layer == 0) {
            { pg8::Gemm g{(const bf16_t*)(ws + W_UCS), HB, 512, TP, DM}; pg8::StaticOrder S; S.init(512, TP, G, bx);
              EpiUcs E{(bf16_t*)(ws + WS_UCST), rowss};
#ifndef NO_G_UCS
              for (int rep = 0; rep < REP_IN; ++rep)
              pg8::gemm_phase<EpiUcs, pg8::StaticOrder, true, true>(lds3, g, S, E);
#endif
            }
            { pg8::Gemm g{HB, (const bf16_t*)(ws + W_QKV), TP, NQKV, DM}; pg8::StaticOrder S; S.init(TP, NQKV, G, G - 1 - bx);
              EpiAct<0> E{(bf16_t*)(ws + WS_ZQ), NQKV, rowss};
#ifndef NO_G_A0
              for (int rep = 0; rep < REP_IN; ++rep)
              pg8::gemm_phase<EpiAct<0>, pg8::StaticOrder, true, true>(lds3, g, S, E);
#endif
            }
            if (bx >= 2 && bx < 123) gen_adft(P, bx - 2, 121);
            GSYNC();
#ifdef REP_EW
            qk_norm_rope(P, (int)(P.c_lb != nullptr));
#endif
            qk_norm_rope(P);
            GSYNC();
#pragma nounroll
            for (int rep = 0; rep < REP_ATTN; ++rep)
            for (int u = bx; u < NB * 6 * 16 + 16; u += G) {
                int b, h, qb;
                if (u < NB * 96) { b = bx & 7; const int ul = (bx >> 3) + 32 * (u >> 8); h = ul >> 4; qb = ul & 15; } else { const int m = u - NB * 96; b = m & 7; h = m >> 3; qb = 16; }
#ifndef NO_ATTN
                att::attn_unit((const bf16_t*)(ws + WS_ZQ), Y, b, h, qb, (char*)lds);
#endif
            }
            if (bx >= 152) weight_jobs(P, lds, 1, 8, bx - 152, G - 152);
            { pg8::Gemm g{(const bf16_t*)(ws + WS_ADFT), (const bf16_t*)(ws + WS_UCST), MF, 2048, KF}; pg8::StaticOrder S; S.init(MF, 2048, 136, bx - 16);
              EpiFour E{Y};
#ifndef NO_G_FOUR
              if (bx >= 16 && bx < 152)
#pragma nounroll
              for (int rep = 0; rep < REP_FOUR; ++rep)
              pg8::gemm_phase<EpiFour, pg8::StaticOrder, true, true>(lds3, g, S, E);
#endif
            }
            GSYNC();
        } else {
            { pg8::Gemm g{HB, (const bf16_t*)(ws + W_C), NREAL, NC, DM}; pg8::StaticOrder S; S.init(NREAL, NC, G, bx);
              EpiHgrn E{(bf16_t*)(ws + WS_Z1), rowss + 2 * (size_t)TP, (const float*)(ws + WS_LB)};
#ifndef NO_G_HGRN
              for (int rep = 0; rep < REP_HG; ++rep)
              pg8::gemm_phase<EpiHgrn, pg8::StaticOrder, true, true>(lds3, g, S, E);
#endif
            }
            { MetaHgrn E{(bf16_t*)(ws + WS_Z1), rowss + 2 * (size_t)TP, (const float*)(ws + WS_LB)};
              for (int rep = 0; rep < REP_META; ++rep) meta_gemm(HB + (size_t)NREAL * DM, DM, (const bf16_t*)(ws + W_C), DM, NC, E, lds); }
            GSYNC();
#pragma nounroll
            for (int rep = 0; rep < REP_SCAN; ++rep)
            for (int u = bx; u < NB * 8 * 4; u += G) {
                const int slot = u >> 3, grp = (u & 7) * 8 + (slot >> 2); const int b = grp >> 3, h = grp & 7, vs = (slot >> 1) & 1, dir = slot & 1;
#ifndef NO_SCAN
                scan_unit((const bf16_t*)(ws + WS_Z1), dir ? Y : (bf16_t*)P.out, b, h, dir, vs, lds, rep + 1 < REP_SCAN ? SCAN_DRY : 0);
#endif
            }
            GSYNC();
#if defined(STOP_AT) && STOP_AT == 5
            { const int tid = otid(); for (long i = (long)bx * 512 + tid; i < (long)NB * SEQ * DM; i += (long)G * 512) P.out[i] = b2f(HB[i]); return; }
#endif
#ifdef REP_EW
            hgrn_finalize(P, (int)(P.c_lb != nullptr));
#endif
            hgrn_finalize(P);
            GSYNC();
#if defined(STOP_AT) && STOP_AT == 6
            { const int tid = otid(); for (long i = (long)bx * 512 + tid; i < (long)NB * SEQ * DM; i += (long)G * 512) P.out[i] = b2f(Y[i]); return; }
#endif
        }
#if defined(STOP_AT) && STOP_AT == 1
        if (layer == 0) return;
#endif
#if defined(STOP_AT) && STOP_AT == 4
        if (layer == 1) return;
#endif
        int bxl = bx, Gl = G; asm volatile("" : "+s"(bxl), "+s"(Gl));
        const int MG = NREAL;
        { pg8::Gemm g{Y, (const bf16_t*)(ws + W_O0 + (size_t)layer * 2 * MiB), MG, DM, DM}; pg8::StaticOrder S; S.init(MG, DM, Gl, bxl);
          EpiRes E{HB, rowss + (size_t)(1 + 2 * layer) * TP};
#ifndef NO_G_RES
          pg8::gemm_phase<EpiRes, pg8::StaticOrder, true, true>(lds3, g, S, E);
#endif
            }
        if (layer == 0) { MetaRes E{HB, rowss + (size_t)TP}; meta_gemm(Y + (size_t)NREAL * DM, DM, (const bf16_t*)(ws + W_O0), DM, DM, E, lds); }
        GSYNC();
#if defined(STOP_AT) && STOP_AT == 2
        if (layer == 0) return;
#endif
        { pg8::Gemm g{HB, (const bf16_t*)(ws + W_1_0 + (size_t)layer * 8 * MiB), MG, DFF, DM}; pg8::StaticOrder S; S.init(MG, DFF, Gl, bxl);
          EpiAct<1> E{(bf16_t*)(ws + WS_HID), DFF, rowss + (size_t)(1 + 2 * layer) * TP};
#ifndef NO_G_A1
#pragma nounroll
          for (int rep = 0; rep < REP_UP; ++rep)
          pg8::gemm_phase<EpiAct<1>, pg8::StaticOrder, true, true>(lds3, g, S, E);
#endif
            }
        if (layer == 0) { MetaUp E{(bf16_t*)(ws + WS_HID), rowss + (size_t)TP}; for (int rep = 0; rep < REP_META; ++rep) meta_gemm(HB + (size_t)NREAL * DM, DM, (const bf16_t*)(ws + W_1_0), DM, DFF, E, lds); }
        GSYNC();
        { pg8::Gemm g{(const bf16_t*)(ws + WS_HID), (const bf16_t*)(ws + W_2_0 + (size_t)layer * 8 * MiB), MG, DM, DFF}; pg8::StaticOrder S; S.init(MG, DM, Gl, bxl);
          EpiRes E{HB, rowss + (size_t)(2 + 2 * layer) * TP};
#ifdef REP_DOWN
          { EpiDummy ED{(float*)P.c_lb == nullptr ? (float*)(ws + WS_Y) : nullptr}; pg8::gemm_phase<EpiDummy, pg8::StaticOrder, true, true>(lds3, g, S, ED); }
#endif
#ifndef NO_G_RES
          pg8::gemm_phase<EpiRes, pg8::StaticOrder, true, true>(lds3, g, S, E);
#endif
            }
        if (layer == 0) { MetaRes E{HB, rowss + 2 * (size_t)TP}; meta_gemm((const bf16_t*)(ws + WS_HID) + (size_t)NREAL * DFF, DFF, (const bf16_t*)(ws + W_2_0), DFF, DM, E, lds); }
        GSYNC();
#if defined(STOP_AT) && STOP_AT == 3
        if (layer == 0) return;
#endif
    }
    const int tid = otid(), lane = tid & 63, wid = tid >> 6;
#ifdef REP_EW
    for (int rep = 0; rep < 2; ++rep)
#endif
    for (int orow = bx * 8 + wid; orow < NB * SEQ; orow += G * 8) {
        const float rs = rstd_of(rowss[(size_t)4 * TP + orow]);
        float* hp = P.out + (size_t)orow * DM; const bf16_t* hb = HB + (size_t)orow * DM;
#pragma unroll
        for (int i = 0; i < 4; ++i) {
            const int col = i * 256 + lane * 4;
            const u32x2 hw = *(const u32x2*)(hb + col); const f32x4 g = *(const f32x4*)(P.final_gain + col);
            const f32x4 v = {blo(hw.x), bhi(hw.x), blo(hw.y), bhi(hw.y)};
            *(f32x4*)(hp + col) = v * rs * g;
        }
    }
}

extern "C" void kernel_launch(void* const* d_in, const int* in_sizes, int n_in, void* d_out, int out_size, void* d_ws, size_t ws_size, hipStream_t stream) {
    static int grid_blocks = 0;
    if (grid_blocks == 0) {
        if (n_in != 15 || out_size != NB * SEQ * DM || ws_size < WS_NEED) { fprintf(stderr, "kernel_launch: unexpected shapes (n_in %d out %d ws %zu, need %zu)\n", n_in, out_size, ws_size, (size_t)WS_NEED); grid_blocks = -1; return; }
        int dev = 0, cus = 0, per_cu = 0;
        hipGetDevice(&dev);
        hipDeviceGetAttribute(&cus, hipDeviceAttributeMultiprocessorCount, dev);
        if (hipFuncSetAttribute((const void*)fwd_megakernel, hipFuncAttributeMaxDynamicSharedMemorySize, LDS_BYTES) != hipSuccess) { fprintf(stderr, "kernel_launch: hipFuncSetAttribute failed\n"); grid_blocks = -1; return; }
        if (hipOccupancyMaxActiveBlocksPerMultiprocessor(&per_cu, (const void*)fwd_megakernel, 512, LDS_BYTES) != hipSuccess || per_cu < 1) { fprintf(stderr, "kernel_launch: occupancy query gave %d\n", per_cu); per_cu = 1; }
        (void)hipGetLastError();
        if (cus < 256) { fprintf(stderr, "kernel_launch: needs 256 CUs, found %d\n", cus); grid_blocks = -1; return; }
        grid_blocks = 256;
    }
    if (grid_blocks < 0) return;
    Params p{};
    p.x = (const float*)d_in[0]; p.meta = (const float*)d_in[1]; p.mix_gain = (const float*)d_in[2]; p.ab_w_in = (const float*)d_in[3];
    p.ab_q_gain = (const float*)d_in[4]; p.ab_k_gain = (const float*)d_in[5]; p.ab_w_out = (const float*)d_in[6]; p.c_w_in = (const float*)d_in[7];
    p.c_lb = (const float*)d_in[8]; p.c_o_gain = (const float*)d_in[9]; p.c_w_out = (const float*)d_in[10]; p.mlp_gain = (const float*)d_in[11];
    p.mlp_w1 = (const float*)d_in[12]; p.mlp_w2 = (const float*)d_in[13]; p.final_gain = (const float*)d_in[14];
    p.out = (float*)d_out; p.ws = (unsigned char*)d_ws;
    if (hipMemsetAsync((char*)d_ws + WS_BAR, 0, 8192, stream) != hipSuccess) { fprintf(stderr, "kernel_launch: memset failed\n"); return; }
    void* args[] = {&p};
    hipError_t e = hipLaunchCooperativeKernel((const void*)fwd_megakernel, dim3(grid_blocks), dim3(512), args, LDS_BYTES, stream);
    if (e != hipSuccess) fprintf(stderr, "kernel_launch: cooperative launch failed: %s (grid %d)\n", hipGetErrorString(e), grid_blocks);
}
```

```cpp
#include <hip/hip_runtime.h>
#include <hip/hip_cooperative_groups.h>
#include <hip/hip_bf16.h>
#include <cstdio>
#include <cstdint>
namespace cg = cooperative_groups;
namespace pg8 {
#define PG8_LAS __attribute__((address_space(3)))
typedef unsigned short bf16_t;
typedef short bf16x8 __attribute__((ext_vector_type(8)));
typedef _Float16 f16x8 __attribute__((ext_vector_type(8)));
typedef float f32x4 __attribute__((ext_vector_type(4)));
typedef unsigned u32x4 __attribute__((ext_vector_type(4)));
constexpr int BM = 256, BK = 64, HALF = 128, HTB = HALF * BK * 2  , STAGE_BYTES = 8 * HTB, NXCD = 8, WGM = 4;

__host__ __device__ __forceinline__ int lds_byte(int r, int c) { const int st = (r >> 4) * 2 + (c >> 5), rr = r & 15, cc = c & 31, ob = rr * 64 + cc * 2; return st * 1024 + (ob ^ (((ob >> 9) & 1) << 5)); }
__host__ __device__ __forceinline__ void stage_rc(int b, int& R, int& C) { const int st = b / 1024, sb = b % 1024, swz = sb ^ (((sb >> 9) & 1) << 5); R = (st >> 1) * 16 + swz / 64; C = (st & 1) * 32 + (swz % 64) / 2; }
__host__ __device__ __forceinline__ int perm32(int rho) { const int n = rho >> 4, i = rho & 15; return 8 * (i >> 2) + 4 * n + (i & 3); }

struct Unit { int pm, pn; };
struct Gemm { const bf16_t* A; const bf16_t* Bt; int M, N, K; };

struct StaticOrder {
    int nM, nN, nwg, G, c;
    __host__ __device__ void init(int M, int N, int G_, int c_) { nM = M / BM; nN = N / BM; nwg = nM * nN; G = G_; c = c_; }
    __host__ __device__ bool next(int i, Unit& u) const {
        const long L = (long)i * G + c; if (L >= nwg) return false;
        int wgid = (int)L; { const int q = nwg / NXCD, r = nwg % NXCD, xcd = wgid % NXCD, off = wgid / NXCD; wgid = (xcd < r ? xcd * (q + 1) : r * (q + 1) + (xcd - r) * q) + off; }
        const int nig = WGM * nN, gid = wgid / nig, fm = gid * WGM, gsz = (nM - fm) < WGM ? (nM - fm) : WGM;
        u.pm = fm + ((wgid % nig) % gsz); u.pn = (wgid % nig) / gsz; return true;
    }
    __device__ __forceinline__ void a_ready(const Unit&) const {}
    __device__ __forceinline__ void done(const Unit&) const {}
};

__device__ __forceinline__ unsigned cvt_pk_bf16(float lo, float hi) { unsigned r; asm volatile("v_cvt_pk_bf16_f32 %0, %1, %2" : "=v"(r) : "v"(lo), "v"(hi)); return r; }
typedef float f32x2 __attribute__((ext_vector_type(2)));
template <class Epi, class Sched, bool ALIGN_EPI = false, bool SP2 = false>
__device__ __forceinline__ void gemm_phase(PG8_LAS unsigned char* lds, const Gemm g, const Sched& S, const Epi& E) {
    int tid_o = threadIdx.x; asm volatile("" : "+v"(tid_o));
    const int tid = tid_o, wid = __builtin_amdgcn_readfirstlane(tid >> 6), lane = tid & 63, wr = wid >> 2, wc = wid & 3, fr = lane & 15, fq = lane >> 4;
    const int K = g.K, nt = K / BK;
    unsigned voffA[2], voffB[2];
#pragma unroll
    for (int i = 0; i < 2; ++i) { int R, C; stage_rc(tid * 16 + i * 8192, R, C); const int Rb = Epi::PERM ? ((R & ~31) + perm32(R & 31)) : R;
        voffA[i] = (unsigned)(R * K + C) * 2u; voffB[i] = (unsigned)(Rb * K + C) * 2u; }
    const size_t kstep = (size_t)(BK * 2);
    const size_t hstep = (size_t)HALF * K * 2;
    const size_t tstep = 2 * hstep;
    const unsigned ldsw = (unsigned)wid * 1024u;
    const int aoff = lds_byte(wr * 64 + fr, fq * 8), boff = lds_byte(wc * 32 + fr, fq * 8);
#define PG8_SA(b, h) (((b) * 2 + (h)) * HTB)
#define PG8_SB(b, h) ((4 + (b) * 2 + (h)) * HTB)
#define PG8_STAGE(bufoff, gbase, voff) do { _Pragma("unroll") for (int _i = 0; _i < 2; ++_i) \
        __builtin_amdgcn_global_load_lds((const unsigned*)((const char*)(gbase) + (voff)[_i]), (PG8_LAS unsigned*)(lds + (bufoff) + ldsw + _i * 8192), 16, 0, 0); } while (0)
#define PG8_LDA(dst, b, h) do { _Pragma("unroll") for (int m = 0; m < 4; ++m) _Pragma("unroll") for (int k = 0; k < 2; ++k) dst[m][k] = *(const PG8_LAS bf16x8*)(lds + PG8_SA(b, h) + aoff + m * 2048 + k * 1024); } while (0)
#define PG8_LDB(dst, b, h) do { _Pragma("unroll") for (int n = 0; n < 2; ++n) _Pragma("unroll") for (int k = 0; k < 2; ++k) dst[n][k] = *(const PG8_LAS bf16x8*)(lds + PG8_SB(b, h) + boff + n * 2048 + k * 1024); } while (0)
#define PG8_MMA(ai, bj, At, Bt) do { __builtin_amdgcn_s_setprio(1); _Pragma("unroll") for (int m = 0; m < 4; ++m) _Pragma("unroll") for (int n = 0; n < 2; ++n) _Pragma("unroll") for (int k = 0; k < 2; ++k) \
        acc[ai][bj][m][n] = __builtin_amdgcn_mfma_f32_16x16x32_f16(__builtin_bit_cast(pg8::f16x8, Bt[n][k]), __builtin_bit_cast(pg8::f16x8, At[m][k]), acc[ai][bj][m][n], 0, 0, 0); __builtin_amdgcn_s_setprio(0); } while (0)
#define PG8_WAIT_V(n) asm volatile("s_waitcnt vmcnt(" #n ")" ::: "memory")
#define PG8_WAIT_L(n) asm volatile("s_waitcnt lgkmcnt(" #n ")" ::: "memory")
#define PG8_BAR __builtin_amdgcn_s_barrier()
#define PG8_SCHED __builtin_amdgcn_sched_barrier(0)
    Unit cur, nxt; int ui = 0;
    if (!S.next(0, cur)) return;
    f32x4 acc[2][2][4][2];
#pragma unroll
    for (int a = 0; a < 2; ++a)
#pragma unroll
        for (int b = 0; b < 2; ++b)
#pragma unroll
            for (int m = 0; m < 4; ++m)
#pragma unroll
                for (int n = 0; n < 2; ++n) acc[a][b][m][n] = (f32x4){0.f, 0.f, 0.f, 0.f};
    bf16x8 At[4][2], B0[2][2], B1[2][2];
    const char* cA = (const char*)g.A + (size_t)cur.pm * tstep; const char* cB = (const char*)g.Bt + (size_t)cur.pn * tstep;
    S.a_ready(cur);
    if constexpr (SP2) {
        PG8_STAGE(PG8_SB(0, 0), cB, voffB); PG8_STAGE(PG8_SB(0, 1), cB + hstep, voffB); PG8_STAGE(PG8_SA(0, 0), cA, voffA); PG8_STAGE(PG8_SA(0, 1), cA + hstep, voffA);
        if (wr == 1) PG8_BAR;
        PG8_WAIT_V(2); PG8_BAR;
        PG8_STAGE(PG8_SB(1, 0), cB + kstep, voffB); PG8_STAGE(PG8_SA(1, 0), cA + kstep, voffA); PG8_STAGE(PG8_SB(1, 1), cB + hstep + kstep, voffB);
        PG8_WAIT_V(6); PG8_BAR;
    } else {
        PG8_STAGE(PG8_SB(0, 0), cB, voffB); PG8_STAGE(PG8_SA(0, 0), cA, voffA); PG8_STAGE(PG8_SB(0, 1), cB + hstep, voffB); PG8_STAGE(PG8_SA(0, 1), cA + hstep, voffA);
        if (wr == 1) PG8_BAR;
        PG8_WAIT_V(4); PG8_BAR;
        PG8_STAGE(PG8_SB(1, 0), cB + kstep, voffB); PG8_STAGE(PG8_SA(1, 0), cA + kstep, voffA); PG8_STAGE(PG8_SB(1, 1), cB + hstep + kstep, voffB);
        PG8_WAIT_V(6); PG8_BAR;
    }
    for (;;) {
        const bool has_next = S.next(ui + 1, nxt);
        const char* nA = has_next ? (const char*)g.A + (size_t)nxt.pm * tstep : cA; const char* nB = has_next ? (const char*)g.Bt + (size_t)nxt.pn * tstep : cB;
        for (int t = 0; t < nt; t += 2) {
            const bool last = (t == nt - 2);
            const char* a1 = cA + (size_t)(t + 1) * kstep;
            const char* a2 = last ? nA : cA + (size_t)(t + 2) * kstep; const char* b2 = last ? nB : cB + (size_t)(t + 2) * kstep;
            const char* a3 = a2 + kstep; const char* b3 = b2 + kstep;
            if (last && has_next) S.a_ready(nxt);
            if constexpr (SP2) {
            PG8_LDB(B0, 0, 0); PG8_LDB(B1, 0, 1); PG8_SCHED; PG8_LDA(At, 0, 0); PG8_STAGE(PG8_SA(1, 1), a1 + hstep, voffA);
            PG8_WAIT_V(8); PG8_WAIT_L(0); PG8_BAR; PG8_MMA(0, 0, At, B0); PG8_MMA(0, 1, At, B1); PG8_BAR; PG8_SCHED;
            PG8_LDA(At, 0, 1); PG8_STAGE(PG8_SB(0, 0), b2, voffB); PG8_STAGE(PG8_SB(0, 1), b2 + hstep, voffB); PG8_STAGE(PG8_SA(0, 0), a2, voffA);
            PG8_WAIT_V(8); PG8_WAIT_L(0); PG8_BAR; PG8_MMA(1, 0, At, B0); PG8_MMA(1, 1, At, B1); PG8_BAR; PG8_SCHED;
            PG8_LDB(B0, 1, 0); PG8_LDB(B1, 1, 1); PG8_SCHED; PG8_LDA(At, 1, 0); PG8_STAGE(PG8_SA(0, 1), a2 + hstep, voffA);
            PG8_WAIT_V(8); PG8_WAIT_L(0); PG8_BAR; PG8_MMA(0, 0, At, B0); PG8_MMA(0, 1, At, B1); PG8_BAR; PG8_SCHED;
            PG8_LDA(At, 1, 1); PG8_STAGE(PG8_SB(1, 0), b3, voffB); PG8_STAGE(PG8_SB(1, 1), b3 + hstep, voffB); PG8_STAGE(PG8_SA(1, 0), a3, voffA);
            PG8_WAIT_V(8); PG8_WAIT_L(0); PG8_BAR; PG8_MMA(1, 0, At, B0); PG8_MMA(1, 1, At, B1); PG8_BAR; PG8_SCHED;
            } else {
            PG8_LDB(B0, 0, 0); PG8_SCHED; PG8_LDA(At, 0, 0); PG8_STAGE(PG8_SA(1, 1), a1 + hstep, voffA);
            PG8_WAIT_L(8); PG8_BAR; PG8_WAIT_L(0); PG8_MMA(0, 0, At, B0); PG8_BAR; PG8_SCHED;
            PG8_LDB(B1, 0, 1); PG8_STAGE(PG8_SB(0, 0), b2, voffB);
            PG8_BAR; PG8_WAIT_L(0); PG8_MMA(0, 1, At, B1); PG8_BAR;
            PG8_LDA(At, 0, 1); PG8_STAGE(PG8_SA(0, 0), a2, voffA);
            PG8_BAR; PG8_WAIT_L(0); PG8_MMA(1, 0, At, B0); PG8_BAR; PG8_SCHED;
            PG8_STAGE(PG8_SB(0, 1), b2 + hstep, voffB);
            PG8_WAIT_V(6); PG8_BAR; PG8_MMA(1, 1, At, B1); PG8_BAR;
            PG8_LDB(B0, 1, 0); PG8_SCHED; PG8_LDA(At, 1, 0); PG8_STAGE(PG8_SA(0, 1), a2 + hstep, voffA);
            PG8_WAIT_L(8); PG8_BAR; PG8_WAIT_L(0); PG8_MMA(0, 0, At, B0); PG8_BAR; PG8_SCHED;
            PG8_LDB(B1, 1, 1); PG8_STAGE(PG8_SB(1, 0), b3, voffB);
            PG8_BAR; PG8_WAIT_L(0); PG8_MMA(0, 1, At, B1); PG8_BAR;
            PG8_LDA(At, 1, 1); PG8_STAGE(PG8_SA(1, 0), a3, voffA);
            PG8_BAR; PG8_WAIT_L(0); PG8_MMA(1, 0, At, B0); PG8_BAR; PG8_SCHED;
            PG8_STAGE(PG8_SB(1, 1), b3 + hstep, voffB);
            PG8_WAIT_V(6); PG8_BAR; PG8_MMA(1, 1, At, B1); PG8_BAR;
            }
        }
        if constexpr (ALIGN_EPI) { if (wr == 0) PG8_BAR; }
        if constexpr (!Epi::AFTER_DRAIN) { E(acc, cur, wr, wc, fr, fq); S.done(cur); }
        if (!has_next) break;
#pragma unroll
        for (int a = 0; a < 2; ++a)
#pragma unroll
            for (int b = 0; b < 2; ++b)
#pragma unroll
                for (int m = 0; m < 4; ++m)
#pragma unroll
                    for (int n = 0; n < 2; ++n) acc[a][b][m][n] = (f32x4){0.f, 0.f, 0.f, 0.f};
        cur = nxt; cA = nA; cB = nB; ++ui;
        if constexpr (ALIGN_EPI) { if (wr == 1) PG8_BAR; }
    }
    PG8_WAIT_V(0);
    if constexpr (!ALIGN_EPI) { if (wr == 0) PG8_BAR; }
    PG8_BAR;
    if constexpr (Epi::AFTER_DRAIN) { E.fused(acc, cur, wr, wc, fr, fq, lds, wid, lane); S.done(cur); }
#undef PG8_SA
#undef PG8_SB
#undef PG8_STAGE
#undef PG8_LDA
#undef PG8_LDB
#undef PG8_MMA
#undef PG8_WAIT_V
#undef PG8_WAIT_L
#undef PG8_BAR
#undef PG8_SCHED
}
}

typedef unsigned short bf16_t;
typedef short bf16x8 __attribute__((ext_vector_type(8)));
typedef short s16x4 __attribute__((ext_vector_type(4)));
typedef float f32x4 __attribute__((ext_vector_type(4)));
typedef float f32x16 __attribute__((ext_vector_type(16)));
typedef unsigned u32x4 __attribute__((ext_vector_type(4)));
typedef unsigned u32x2 __attribute__((ext_vector_type(2)));
#define LAS3 __attribute__((address_space(3)))

constexpr int DM = 1024, NB = 8, SEQ = 4096, LT = 4112, T = NB * LT, TP = 33024, NREAL = NB * SEQ;
constexpr int NQKV = 1280, DFF = 4096, NC = 5120;
constexpr int LK = 4160, KF = 2 * LK, MF = 4352;
constexpr float EPS = 1e-6f;
constexpr size_t MiB = 1u << 20;
constexpr size_t WS_ROWSS = 0;
constexpr size_t WS_LB = 704512;
constexpr size_t WS_BAR = 720896;
constexpr size_t WS_HMETA = 1 * MiB;
constexpr size_t W_UCS = 2 * MiB;
constexpr size_t W_QKV = W_UCS + 1 * MiB;
constexpr size_t W_O0 = W_QKV + 2560 * 1024;
constexpr size_t W_1_0 = W_O0 + 4 * MiB;
constexpr size_t W_2_0 = W_1_0 + 16 * MiB;
constexpr size_t W_C = W_2_0 + 16 * MiB;
constexpr size_t W_END = W_C + 10 * MiB;
constexpr size_t WS_HB = 52 * MiB;
constexpr size_t WS_Y = 117 * MiB;
constexpr size_t WS_BIG = 182 * MiB;
constexpr size_t WS_ZQ = WS_BIG, WS_UCST = WS_BIG + 81 * MiB, WS_ADFT = WS_BIG + 114 * MiB, WS_HID = WS_BIG, WS_Z1 = WS_BIG;
constexpr size_t WS_NEED = WS_BIG + (size_t)TP * NC * 2;
static_assert(W_END <= WS_HB && WS_HB + (size_t)TP * DM * 2 <= WS_Y && WS_Y + (size_t)TP * DM * 2 <= WS_BIG, "ws map");
static_assert(WS_ZQ + (size_t)TP * NQKV * 2 <= WS_UCST && WS_UCST + (size_t)2048 * KF * 2 <= WS_ADFT && WS_ADFT + (size_t)MF * KF * 2 <= WS_NEED, "ws map 2");
static_assert(WS_NEED <= 512 * MiB, "ws size");
constexpr int LDS_BYTES = 147456;

struct Params {
    const float* x; const float* meta; const float* mix_gain; const float* ab_w_in; const float* ab_q_gain; const float* ab_k_gain; const float* ab_w_out;
    const float* c_w_in; const float* c_lb; const float* c_o_gain; const float* c_w_out; const float* mlp_gain; const float* mlp_w1; const float* mlp_w2; const float* final_gain;
    float* out; unsigned char* ws;
};

typedef _Float16 f16x2 __attribute__((ext_vector_type(2)));
typedef _Float16 f16x8 __attribute__((ext_vector_type(8)));
typedef float f32x2 __attribute__((ext_vector_type(2)));
__device__ __forceinline__ unsigned pk2(float lo, float hi) { const f32x2 v = {lo, hi}; const f16x2 h = __builtin_convertvector(v, f16x2); return __builtin_bit_cast(unsigned, h); }
__device__ __forceinline__ bf16_t f2b(float v) { const _Float16 h = (_Float16)v; return __builtin_bit_cast(unsigned short, h); }
__device__ __forceinline__ float b2f(bf16_t v) { return (float)__builtin_bit_cast(_Float16, v); }
__device__ __forceinline__ float blo(unsigned w) { return b2f((bf16_t)(w & 0xffffu)); }
__device__ __forceinline__ float bhi(unsigned w) { return b2f((bf16_t)(w >> 16)); }
__device__ __forceinline__ unsigned pk2_bf(float lo, float hi) { unsigned r; asm volatile("v_cvt_pk_bf16_f32 %0, %1, %2" : "=v"(r) : "v"(lo), "v"(hi)); return r; }
__device__ __forceinline__ bf16_t f2bf(float v) { return (bf16_t)(pk2_bf(v, v) & 0xffffu); }
__device__ __forceinline__ f32x16 mfma32(bf16x8 a, bf16x8 b, f32x16 c) { return __builtin_amdgcn_mfma_f32_32x32x16_f16(__builtin_bit_cast(f16x8, a), __builtin_bit_cast(f16x8, b), c, 0, 0, 0); }
__device__ __forceinline__ const Params& KP() { const void* p = (const void*)__builtin_amdgcn_kernarg_segment_ptr(); asm volatile("" : "+s"(p)); return *(const Params*)p; }
__device__ __forceinline__ int otid() { int t = threadIdx.x; asm volatile("" : "+v"(t)); return t; }
__device__ __forceinline__ int crow(int r, int hi) { return (r & 3) + 8 * (r >> 2) + 4 * hi; }
__device__ __forceinline__ float wave_sum(float v) {
#pragma unroll
    for (int o = 32; o > 0; o >>= 1) v += __shfl_xor(v, o);
    return v;
}
__device__ __forceinline__ float rstd_of(float ss) { return rsqrtf(ss * (1.0f / 1024.0f) + EPS); }
template <int ACT> struct EpiAct {
    static constexpr bool PERM = true, AFTER_DRAIN = false;
    bf16_t* O; int ldc; const float* rowss;
    __device__ __forceinline__ void operator()(const f32x4 (&acc)[2][2][4][2], const pg8::Unit& u, int wr, int wc, int fr, int fq) const {
        const int row0 = u.pm * 256 + wr * 64 + fr, col0 = u.pn * 256 + wc * 32 + 8 * fq;
        float rsv[2][4];
#pragma unroll
        for (int ai = 0; ai < 2; ++ai)
#pragma unroll
            for (int m = 0; m < 4; ++m) rsv[ai][m] = rowss[row0 + ai * 128 + m * 16];
#pragma unroll
        for (int ai = 0; ai < 2; ++ai)
#pragma unroll
            for (int m = 0; m < 4; ++m) rsv[ai][m] = rstd_of(rsv[ai][m]);
#pragma unroll
        for (int ai = 0; ai < 2; ++ai)
#pragma unroll
            for (int m = 0; m < 4; ++m) {
                const int row = row0 + ai * 128 + m * 16; const float rs = rsv[ai][m];
                bf16_t* rowp = O + (size_t)row * ldc + col0;
#pragma unroll
                for (int bj = 0; bj < 2; ++bj) {
                    f32x4 v0 = acc[ai][bj][m][0] * rs, v1 = acc[ai][bj][m][1] * rs;
                    if (ACT == 1) {
#pragma unroll
                        for (int j = 0; j < 4; ++j) { float a = fmaxf(v0[j], 0.f), b = fmaxf(v1[j], 0.f); v0[j] = a * a; v1[j] = b * b; }
                    }
                    u32x4 w; w.x = pk2(v0[0], v0[1]); w.y = pk2(v0[2], v0[3]); w.z = pk2(v1[0], v1[1]); w.w = pk2(v1[2], v1[3]);
                    __builtin_nontemporal_store(w, (u32x4*)(rowp + bj * 128));
                }
            }
    }
};
struct EpiUcs {
    static constexpr bool PERM = true, AFTER_DRAIN = false;
    bf16_t* U; const float* rowss;
    __device__ __forceinline__ void operator()(const f32x4 (&acc)[2][2][4][2], const pg8::Unit& u, int wr, int wc, int fr, int fq) const {
        const int part = u.pm;
        f32x4 sv[2][2];
#pragma unroll
        for (int bj = 0; bj < 2; ++bj) { const int t0 = u.pn * 256 + bj * 128 + wc * 32 + 8 * fq; sv[bj][0] = *(const f32x4*)(rowss + t0); sv[bj][1] = *(const f32x4*)(rowss + t0 + 4); }
#pragma unroll
        for (int bj = 0; bj < 2; ++bj) {
            const int t0 = u.pn * 256 + bj * 128 + wc * 32 + 8 * fq;
            if (t0 < T) {
                int b, p; if (t0 < NREAL) { b = t0 >> 12; p = 16 + (t0 & 4095); } else { b = (t0 - NREAL) >> 4; p = (t0 - NREAL) & 15; }
                const f32x4 s0 = sv[bj][0], s1 = sv[bj][1];
                f32x4 r0, r1; r0[0] = rstd_of(s0[0]); r0[1] = rstd_of(s0[1]); r0[2] = rstd_of(s0[2]); r0[3] = rstd_of(s0[3]); r1[0] = rstd_of(s1[0]); r1[1] = rstd_of(s1[1]); r1[2] = rstd_of(s1[2]); r1[3] = rstd_of(s1[3]);
#pragma unroll
                for (int ai = 0; ai < 2; ++ai)
#pragma unroll
                    for (int m = 0; m < 4; ++m) {
                        const int c = ai * 128 + wr * 64 + m * 16 + fr;
                        const f32x4 v0 = acc[ai][bj][m][0] * r0, v1 = acc[ai][bj][m][1] * r1;
                        u32x4 w; w.x = pk2(v0[0], v0[1]); w.y = pk2(v0[2], v0[3]); w.z = pk2(v1[0], v1[1]); w.w = pk2(v1[2], v1[3]);
                        __builtin_nontemporal_store(w, (u32x4*)(U + (size_t)(b * 256 + c) * KF + part * LK + p));
                    }
            }
        }
    }
};
struct EpiFour {
    static constexpr bool PERM = true, AFTER_DRAIN = false;
    bf16_t* Y;
    __device__ __forceinline__ void operator()(const f32x4 (&acc)[2][2][4][2], const pg8::Unit& u, int wr, int wc, int fr, int fq) const {
        const int row0 = u.pm * 256 + wr * 64 + fr, col0 = wc * 32 + 8 * fq;
#pragma unroll
        for (int ai = 0; ai < 2; ++ai)
#pragma unroll
            for (int m = 0; m < 4; ++m) {
                const int lp = row0 + ai * 128 + m * 16;
                if (lp < LT) {
                    bf16_t* rowp = Y + (size_t)(lp < 16 ? NREAL + u.pn * 16 + lp : u.pn * SEQ + lp - 16) * DM + col0;
#pragma unroll
                    for (int bj = 0; bj < 2; ++bj) {
                        const f32x4 v0 = acc[ai][bj][m][0], v1 = acc[ai][bj][m][1];
                        u32x4 w; w.x = pk2(v0[0], v0[1]); w.y = pk2(v0[2], v0[3]); w.z = pk2(v1[0], v1[1]); w.w = pk2(v1[2], v1[3]);
                        __builtin_nontemporal_store(w, (u32x4*)(rowp + bj * 128));
                    }
                }
            }
    }
};
struct EpiHgrn {
    static constexpr bool PERM = true, AFTER_DRAIN = false;
    bf16_t* O; const float* rowss; const float* lb;
    template <int MODE>
    __device__ __forceinline__ void body(const f32x4 (&acc)[2][2][4][2], const float (&rsv)[2][4], const f32x4 (&lbv)[2][2], int row0, int col0) const {
#pragma unroll
        for (int ai = 0; ai < 2; ++ai)
#pragma unroll
            for (int m = 0; m < 4; ++m) {
                const int row = row0 + ai * 128 + m * 16; const float rs = rsv[ai][m];
                bf16_t* rowp = O + (size_t)row * NC + col0;
#pragma unroll
                for (int bj = 0; bj < 2; ++bj) {
                    f32x4 v[2]; v[0] = acc[ai][bj][m][0] * rs; v[1] = acc[ai][bj][m][1] * rs;
                    if (MODE != 2) {
#pragma unroll
                        for (int n = 0; n < 2; ++n)
#pragma unroll
                            for (int j = 0; j < 4; ++j) {
                                const float x = v[n][j];
                                if (MODE == 0) v[n][j] = x * __builtin_amdgcn_rcpf(1.0f + __expf(-x));
                                else v[n][j] = (1.0f - lbv[bj][n][j]) * __builtin_amdgcn_rcpf(1.0f + __expf(x));
                            }
                    }
                    u32x4 w; w.x = pk2(v[0][0], v[0][1]); w.y = pk2(v[0][2], v[0][3]); w.z = pk2(v[1][0], v[1][1]); w.w = pk2(v[1][2], v[1][3]);
                    __builtin_nontemporal_store(w, (u32x4*)(rowp + bj * 128));
                }
            }
    }
    __device__ __forceinline__ void operator()(const f32x4 (&acc)[2][2][4][2], const pg8::Unit& u, int wr, int wc, int fr, int fq) const {
        const int typ = u.pn >> 2;
        const int row0 = u.pm * 256 + wr * 64 + fr, col0 = u.pn * 256 + wc * 32 + 8 * fq;
        f32x4 lbv[2][2];
#pragma unroll
        for (int bj = 0; bj < 2; ++bj) {
            if (typ == 1 || typ == 2) { const float* lp = lb + (col0 - 1024 + bj * 128); lbv[bj][0] = *(const f32x4*)lp; lbv[bj][1] = *(const f32x4*)(lp + 4); }
            else { lbv[bj][0] = (f32x4){0.f, 0.f, 0.f, 0.f}; lbv[bj][1] = lbv[bj][0]; }
        }
        float rsv[2][4];
#pragma unroll
        for (int ai = 0; ai < 2; ++ai)
#pragma unroll
            for (int m = 0; m < 4; ++m) rsv[ai][m] = rowss[row0 + ai * 128 + m * 16];
#pragma unroll
        for (int ai = 0; ai < 2; ++ai)
#pragma unroll
            for (int m = 0; m < 4; ++m) rsv[ai][m] = rstd_of(rsv[ai][m]);
        if (typ == 3) body<2>(acc, rsv, lbv, row0, col0);
        else if (typ == 1 || typ == 2) body<1>(acc, rsv, lbv, row0, col0);
        else body<0>(acc, rsv, lbv, row0, col0);
    }
};
struct EpiRes {
    static constexpr bool PERM = true, AFTER_DRAIN = false;
    bf16_t* HB; float* rowss_next;
    __device__ __forceinline__ void operator()(const f32x4 (&acc)[2][2][4][2], const pg8::Unit& u, int wr, int wc, int fr, int fq) const {
        const int row0 = u.pm * 256 + wr * 64 + fr, col0 = u.pn * 256 + wc * 32 + 8 * fq;
#pragma unroll
        for (int ai = 0; ai < 2; ++ai)
#pragma unroll
            for (int m = 0; m < 4; ++m) {
                const int row = row0 + ai * 128 + m * 16;
                float ss = 0.f;
                {
                    bf16_t* bp = HB + (size_t)row * DM + col0;
                    const u32x4 o0 = *(const u32x4*)bp, o1 = *(const u32x4*)(bp + 128);
#pragma unroll
                    for (int bj = 0; bj < 2; ++bj) {
                        const u32x4 o = bj ? o1 : o0;
                        const f32x4 a0 = acc[ai][bj][m][0], a1 = acc[ai][bj][m][1];
                        u32x4 w;
                        w.x = pk2(blo(o.x) + a0[0], bhi(o.x) + a0[1]); w.y = pk2(blo(o.y) + a0[2], bhi(o.y) + a0[3]);
                        w.z = pk2(blo(o.z) + a1[0], bhi(o.z) + a1[1]); w.w = pk2(blo(o.w) + a1[2], bhi(o.w) + a1[3]);
                        __builtin_nontemporal_store(w, (u32x4*)(bp + bj * 128));
                        const float h0 = blo(w.x), h1 = bhi(w.x), h2 = blo(w.y), h3 = bhi(w.y), h4 = blo(w.z), h5 = bhi(w.z), h6 = blo(w.w), h7 = bhi(w.w);
                        ss += ((h0 * h0 + h1 * h1) + (h2 * h2 + h3 * h3)) + ((h4 * h4 + h5 * h5) + (h6 * h6 + h7 * h7));
                    }
                }
                ss += __shfl_xor(ss, 16); ss += __shfl_xor(ss, 32);
                if (fq == 0) atomicAdd(rowss_next + row, ss);
            }
    }
};

struct EpiDummy {
    static constexpr bool PERM = true, AFTER_DRAIN = false;
    float* sink;
    __device__ __forceinline__ void operator()(const f32x4 (&acc)[2][2][4][2], const pg8::Unit& u, int wr, int wc, int fr, int fq) const {
        if (sink) { f32x4 t = {0.f, 0.f, 0.f, 0.f};
#pragma unroll
            for (int a = 0; a < 2; ++a)
#pragma unroll
                for (int b = 0; b < 2; ++b)
#pragma unroll
                    for (int m = 0; m < 4; ++m) { t += acc[a][b][m][0]; t += acc[a][b][m][1]; }
            *(f32x4*)(sink + (size_t)(u.pm * 4 + u.pn) * 2048 + (wr * 4 + wc) * 256 + (fr * 4 + fq) * 4) = t; }
    }
};
template <class Epi>
__device__ __forceinline__ void meta_gemm(const bf16_t* __restrict__ A, int lda, const bf16_t* __restrict__ Bt, int K, int N, const Epi& E, unsigned char* lds) {
    const int tid = otid(), wid = tid >> 6, lane = tid & 63, l16 = lane & 15, q = lane >> 4;
    float* red = (float*)lds;
    const int ks = K >> 3;
    for (int g = blockIdx.x; g < (N >> 4); g += gridDim.x) {
        const bf16_t* bp = Bt + (size_t)(16 * g + l16) * K + wid * ks + 8 * q;
        const bf16_t* ap = A + (size_t)l16 * lda + wid * ks + 8 * q;
        f32x4 acc[8];
#pragma unroll
        for (int rb = 0; rb < 8; ++rb) acc[rb] = (f32x4){0.f, 0.f, 0.f, 0.f};
#pragma unroll 2
        for (int k = 0; k < ks; k += 32) {
            const f16x8 bf = __builtin_bit_cast(f16x8, *(const bf16x8*)(bp + k));
#pragma unroll
            for (int rb = 0; rb < 8; ++rb)
                acc[rb] = __builtin_amdgcn_mfma_f32_16x16x32_f16(__builtin_bit_cast(f16x8, *(const bf16x8*)(ap + (size_t)(16 * rb) * lda + k)), bf, acc[rb], 0, 0, 0);
        }
#pragma unroll
        for (int rb = 0; rb < 8; ++rb) *(f32x4*)(red + ((wid * 8 + rb) * 64 + lane) * 4) = acc[rb];
        __syncthreads();
        f32x4 sum = {0.f, 0.f, 0.f, 0.f};
#pragma unroll
        for (int w2 = 0; w2 < 8; ++w2) sum += *(const f32x4*)(red + ((w2 * 8 + wid) * 64 + lane) * 4);
        E(NREAL + 16 * wid + 4 * q, 16 * g + l16, sum);
        __syncthreads();
    }
}
struct MetaRes {
    bf16_t* HB; float* rowss_next;
    __device__ __forceinline__ void operator()(int row0, int col, const f32x4& acc) const {
#pragma unroll
        for (int i = 0; i < 4; ++i) {
            bf16_t* p = HB + (size_t)(row0 + i) * DM + col;
            const bf16_t hn = f2b(b2f(*p) + acc[i]); *p = hn;
            float ss = b2f(hn); ss *= ss;
            ss += __shfl_xor(ss, 1); ss += __shfl_xor(ss, 2); ss += __shfl_xor(ss, 4); ss += __shfl_xor(ss, 8);
            if ((threadIdx.x & 15) == 0) atomicAdd(rowss_next + row0 + i, ss);
        }
    }
};
struct MetaUp {
    bf16_t* O; const float* rowss;
    __device__ __forceinline__ void operator()(int row0, int col, const f32x4& acc) const {
#pragma unroll
        for (int i = 0; i < 4; ++i) { const float v = fmaxf(acc[i] * rstd_of(rowss[row0 + i]), 0.f); O[(size_t)(row0 + i) * DFF + col] = f2b(v * v); }
    }
};
struct MetaHgrn {
    bf16_t* O; const float* rowss; const float* lb;
    __device__ __forceinline__ void operator()(int row0, int col, const f32x4& acc) const {
        const int typ = col >> 10;
        const float l = (typ == 1 || typ == 2) ? lb[col - 1024] : 0.f;
#pragma unroll
        for (int i = 0; i < 4; ++i) {
            const float x = acc[i] * rstd_of(rowss[row0 + i]); float r;
            if (typ == 0 || typ == 4) r = x * __builtin_amdgcn_rcpf(1.0f + __expf(-x));
            else if (typ == 3) r = x;
            else r = (1.0f - l) * __builtin_amdgcn_rcpf(1.0f + __expf(x));
            O[(size_t)(row0 + i) * NC + col] = f2b(r);
        }
    }
};

__device__ __forceinline__ void gen_adft(const Params& P, int bx, int G) {
    const int tid = otid(); unsigned char* ws = P.ws;
    const long gtid = (long)bx * 512 + tid, gthreads = (long)G * 512;
    {
        bf16_t* A = (bf16_t*)(ws + WS_ADFT);
        const long nch = (long)MF * (KF / 8);
        for (long ci = gtid; ci < nch; ci += gthreads) {
            const int lp = (int)(ci / (KF / 8)); const int cj = (int)(ci - (long)lp * (KF / 8));
            const int j0 = cj * 8; const int part = j0 >= LK ? 1 : 0; const int l0 = j0 - part * LK;
            u32x4 w = {0u, 0u, 0u, 0u};
            if (lp < LT && l0 < LT) {
                int mm = (int)(((long)lp * l0) % LT);
                float v[8];
#pragma unroll
                for (int e = 0; e < 8; ++e) {
                    const float rev = (float)mm * (1.0f / (float)LT);
                    v[e] = part ? -__builtin_amdgcn_sinf(rev) : __builtin_amdgcn_cosf(rev);
                    mm += lp; if (mm >= LT) mm -= LT;
                }
                w.x = pk2(v[0], v[1]); w.y = pk2(v[2], v[3]); w.z = pk2(v[4], v[5]); w.w = pk2(v[6], v[7]);
            }
            __builtin_nontemporal_store(w, (u32x4*)(A + (size_t)lp * KF + j0));
        }
    }
}

__device__ __forceinline__ void weight_jobs(const Params& P, unsigned char* lds, int job_lo, int job_hi, int bx, int G) {
    const int tid = otid();
    unsigned char* ws = P.ws;
    float* tile = (float*)lds;
#pragma nounroll
    for (int job = job_lo; job < job_hi; ++job) {
        const float* src; int ld, coff, K, N; bf16_t* dst; const float* gain;
        switch (job) {
            case 0: src = P.ab_w_in; ld = 1536; coff = 256; K = 1024; N = 1280; dst = (bf16_t*)(ws + W_QKV); gain = P.mix_gain; break;
            case 1: src = P.ab_w_out; ld = 1024; coff = 0; K = 1024; N = 1024; dst = (bf16_t*)(ws + W_O0); gain = nullptr; break;
            case 2: src = P.mlp_w1; ld = 4096; coff = 0; K = 1024; N = 4096; dst = (bf16_t*)(ws + W_1_0); gain = P.mlp_gain; break;
            case 3: src = P.mlp_w1 + (size_t)1024 * 4096; ld = 4096; coff = 0; K = 1024; N = 4096; dst = (bf16_t*)(ws + W_1_0 + 8 * MiB); gain = P.mlp_gain + 1024; break;
            case 4: src = P.mlp_w2; ld = 1024; coff = 0; K = 4096; N = 1024; dst = (bf16_t*)(ws + W_2_0); gain = nullptr; break;
            case 5: src = P.mlp_w2 + (size_t)4096 * 1024; ld = 1024; coff = 0; K = 4096; N = 1024; dst = (bf16_t*)(ws + W_2_0 + 8 * MiB); gain = nullptr; break;
            case 6: src = P.c_w_in; ld = 5120; coff = 0; K = 1024; N = 5120; dst = (bf16_t*)(ws + W_C); gain = P.mix_gain + 1024; break;
            default: src = P.c_w_out; ld = 1024; coff = 0; K = 1024; N = 1024; dst = (bf16_t*)(ws + W_O0 + 2 * MiB); gain = nullptr; break;
        }
        const int nkt = K >> 6, nnt = N >> 6, ntile = nkt * nnt;
        const int kr = tid >> 3, c8 = (tid & 7) * 8;
        f32x4 ra, rb; float rgn = 1.f;
        if (bx < ntile) { const int kt = bx % nkt, nt = bx / nkt; const float* sp = src + (size_t)(kt * 64 + kr) * ld + coff + nt * 64 + c8; ra = *(const f32x4*)sp; rb = *(const f32x4*)(sp + 4); rgn = gain ? gain[kt * 64 + kr] : 1.0f; }
        for (int ti = bx; ti < ntile; ti += G) {
            const int kt = ti % nkt, nt = ti / nkt, k0 = kt * 64, n0 = nt * 64;
            { float* tp = tile + kr * 65 + c8;
              tp[0] = ra[0] * rgn; tp[1] = ra[1] * rgn; tp[2] = ra[2] * rgn; tp[3] = ra[3] * rgn; tp[4] = rb[0] * rgn; tp[5] = rb[1] * rgn; tp[6] = rb[2] * rgn; tp[7] = rb[3] * rgn; }
            __syncthreads();
            if (ti + G < ntile) {
                const int t2 = ti + G, kt2 = t2 % nkt, nt2 = t2 / nkt; const float* sp = src + (size_t)(kt2 * 64 + kr) * ld + coff + nt2 * 64 + c8;
                ra = *(const f32x4*)sp; rb = *(const f32x4*)(sp + 4); rgn = gain ? gain[kt2 * 64 + kr] : 1.0f; }
            { const int nr = tid >> 3, k8 = (tid & 7) * 8;
              const float* tp = tile + k8 * 65 + nr;
              u32x4 w; w.x = pk2(tp[0], tp[65]); w.y = pk2(tp[130], tp[195]); w.z = pk2(tp[260], tp[325]); w.w = pk2(tp[390], tp[455]);
              __builtin_nontemporal_store(w, (u32x4*)(dst + (size_t)(n0 + nr) * K + k0 + k8)); }
            __syncthreads();
        }
    }
}

__device__ __forceinline__ void p0_prologue(const Params& P, unsigned char* lds) {
    const int tid = otid(), lane = tid & 63, wid = tid >> 6;
    const int G = gridDim.x, bx = blockIdx.x;
    unsigned char* ws = P.ws;
    float* tile = (float*)lds;
    float* twc = (float*)(lds + 64 * 65 * 4);
    float* tws = twc + 64;
    if (tid < 64) { twc[tid] = __builtin_amdgcn_cosf((float)tid * (1.0f / 64.0f)); tws[tid] = __builtin_amdgcn_sinf((float)tid * (1.0f / 64.0f)); }
    __syncthreads();
    weight_jobs(P, lds, 0, 1, bx, G);
    {
        const float scale = 0.0019493177f;
        bf16_t* dst = (bf16_t*)(ws + W_UCS);
        for (int ti = bx; ti < 256; ti += G) {
            const int kt = ti & 63, g = ti >> 6, k0 = kt * 16;
            if (tid < 256) { const int kr = tid >> 4, c4 = (tid & 15) * 4;
              const f32x4 a = *(const f32x4*)(P.ab_w_in + (size_t)(k0 + kr) * 1536 + g * 64 + c4);
              const float gn = P.mix_gain[k0 + kr] * scale;
              float* tp = tile + kr * 65 + c4; tp[0] = a[0] * gn; tp[1] = a[1] * gn; tp[2] = a[2] * gn; tp[3] = a[3] * gn; }
            __syncthreads();
            { const int cp = tid >> 3, k2 = (tid & 7) * 2;
              float ac0 = 0.f, ac1 = 0.f, as0 = 0.f, as1 = 0.f;
              for (int c = 0; c < 64; ++c) {
                  const int mm = (c * cp) & 63; const float cw = twc[mm], sw = tws[mm];
                  const float v0 = tile[k2 * 65 + c], v1 = tile[(k2 + 1) * 65 + c];
                  ac0 += v0 * cw; ac1 += v1 * cw; as0 += v0 * sw; as1 += v1 * sw;
              }
              *(unsigned*)(dst + (size_t)(g * 64 + cp) * DM + k0 + k2) = pk2(ac0, ac1);
              *(unsigned*)(dst + (size_t)(256 + g * 64 + cp) * DM + k0 + k2) = pk2(as0, as1); }
            __syncthreads();
        }
    }
    {
        float* rowss = (float*)(ws + WS_ROWSS); bf16_t* HB = (bf16_t*)(ws + WS_HB); bf16_t* Y = (bf16_t*)(ws + WS_Y);
        const int nw = G * 8;
        for (int row0 = bx * 8 + wid; row0 < TP; row0 += 2 * nw) {
            f32x4 v[2][4];
#pragma unroll
            for (int r = 0; r < 2; ++r) { const int row = row0 + r * nw;
                if (row < T) { const float* src = (row < NREAL ? P.x + (size_t)row * DM : P.meta + (size_t)((row - NREAL) & 15) * DM) + lane * 16;
#pragma unroll
                    for (int i = 0; i < 4; ++i) v[r][i] = *(const f32x4*)(src + 4 * i); }
                else {
#pragma unroll
                    for (int i = 0; i < 4; ++i) v[r][i] = (f32x4){0.f, 0.f, 0.f, 0.f}; } }
#pragma unroll
            for (int r = 0; r < 2; ++r) { const int row = row0 + r * nw;
                if (row < TP) {
                    float ss = 0.f;
#pragma unroll
                    for (int i = 0; i < 4; ++i) ss += (v[r][i][0] * v[r][i][0] + v[r][i][1] * v[r][i][1]) + (v[r][i][2] * v[r][i][2] + v[r][i][3] * v[r][i][3]);
                    u32x4 w0, w1;
                    w0.x = pk2(v[r][0][0], v[r][0][1]); w0.y = pk2(v[r][0][2], v[r][0][3]); w0.z = pk2(v[r][1][0], v[r][1][1]); w0.w = pk2(v[r][1][2], v[r][1][3]);
                    w1.x = pk2(v[r][2][0], v[r][2][1]); w1.y = pk2(v[r][2][2], v[r][2][3]); w1.z = pk2(v[r][3][0], v[r][3][1]); w1.w = pk2(v[r][3][2], v[r][3][3]);
                    *(u32x4*)(HB + (size_t)row * DM + lane * 16) = w0; *(u32x4*)(HB + (size_t)row * DM + lane * 16 + 8) = w1;
                    if (row >= T) { const u32x4 z = {0u, 0u, 0u, 0u}; *(u32x4*)(Y + (size_t)row * DM + lane * 16) = z; *(u32x4*)(Y + (size_t)row * DM + lane * 16 + 8) = z; }
                    ss = wave_sum(ss);
                    if (lane == 0) rowss[row] = ss;
                    if (lane >= 1 && lane < 5) rowss[(size_t)lane * TP + row] = 0.f;
                }
            }
        }
    }
    const long gtid = (long)bx * 512 + tid, gthreads = (long)G * 512;
    if (gtid < 2048) {
        const int dir = (int)gtid >> 10, c = (int)gtid & 1023;
        const float l0 = P.c_lb[dir * 1024 + c], l1 = P.c_lb[2048 + dir * 1024 + c];
        ((float*)(ws + WS_LB))[gtid] = 1.0f / (1.0f + __expf(l0 - l1));
    }
    {
        bf16_t* U = (bf16_t*)(ws + WS_UCST);
        for (long i = gtid; i < 2048 * 12; i += gthreads) {
            const int row = (int)(i / 12), k = (int)(i % 12), seg = k / 6, e = k % 6;
            const u32x4 z = {0u, 0u, 0u, 0u};
            *(u32x4*)(U + (size_t)row * KF + seg * LK + LT + e * 8) = z;
        }
    }
}

__device__ __forceinline__ void qk_norm_rope(const Params& P, int dry = 0) {
    const int tid = otid(), lane = tid & 63, wid = tid >> 6;
    bf16_t* ZQ = (bf16_t*)(P.ws + WS_ZQ);
    const int head = lane >> 3, d0 = (lane & 7) * 8;
    const float* gain = head < 6 ? P.ab_q_gain : P.ab_k_gain;
    float inv[8], g1[8], g2[8];
#pragma unroll
    for (int e = 0; e < 8; ++e) { inv[e] = __builtin_amdgcn_exp2f(-(float)((d0 + e) & 31) * (13.287712379549449f / 32.0f)); g1[e] = gain[d0 + e]; g2[e] = gain[64 + d0 + e]; }
    const int nw = gridDim.x * 8, w0 = blockIdx.x * 8 + wid;
    for (int row = w0; row < T; row += 2 * nw) {
        const int rowb = row + nw; const bool hasb = rowb < T;
        bf16_t* za = ZQ + (size_t)row * NQKV + head * 128 + d0; bf16_t* zb = ZQ + (size_t)(hasb ? rowb : row) * NQKV + head * 128 + d0;
        const u32x4 a1 = *(const u32x4*)za, a2 = *(const u32x4*)(za + 64), b1 = *(const u32x4*)zb, b2 = *(const u32x4*)(zb + 64);
#pragma unroll
        for (int it = 0; it < 2; ++it) {
            const u32x4 w1 = it ? b1 : a1, w2 = it ? b2 : a2; const int r = it ? rowb : row; bf16_t* zp = it ? zb : za;
            float x1[8], x2[8];
            x1[0] = blo(w1.x); x1[1] = bhi(w1.x); x1[2] = blo(w1.y); x1[3] = bhi(w1.y); x1[4] = blo(w1.z); x1[5] = bhi(w1.z); x1[6] = blo(w1.w); x1[7] = bhi(w1.w);
            x2[0] = blo(w2.x); x2[1] = bhi(w2.x); x2[2] = blo(w2.y); x2[3] = bhi(w2.y); x2[4] = blo(w2.z); x2[5] = bhi(w2.z); x2[6] = blo(w2.w); x2[7] = bhi(w2.w);
            float ss = 0.f;
#pragma unroll
            for (int e = 0; e < 8; ++e) ss += x1[e] * x1[e] + x2[e] * x2[e];
            ss += __shfl_xor(ss, 1); ss += __shfl_xor(ss, 2); ss += __shfl_xor(ss, 4);
            const float rs = rsqrtf(ss * (1.0f / 128.0f) + EPS);
            float o1[8], o2[8];
            const bool real = r < NREAL; const int pos = r & 4095; const float pv = (float)((lane & 7) < 4 ? (pos >> 6) : (pos & 63));
#pragma unroll
            for (int e = 0; e < 8; ++e) {
                const float y1 = x1[e] * rs * g1[e], y2 = x2[e] * rs * g2[e];
                float c = 1.f, sn = 0.f;
                if (real) { float rev = pv * inv[e] * 0.15915494309189535f; rev -= floorf(rev); c = __builtin_amdgcn_cosf(rev); sn = __builtin_amdgcn_sinf(rev); }
                o1[e] = y1 * c - y2 * sn; o2[e] = y2 * c + y1 * sn;
            }
            if (!dry && (it == 0 || hasb)) {
                u32x4 v1, v2;
                v1.x = pk2(o1[0], o1[1]); v1.y = pk2(o1[2], o1[3]); v1.z = pk2(o1[4], o1[5]); v1.w = pk2(o1[6], o1[7]);
                v2.x = pk2(o2[0], o2[1]); v2.y = pk2(o2[2], o2[3]); v2.z = pk2(o2[4], o2[5]); v2.w = pk2(o2[6], o2[7]);
                *(u32x4*)zp = v1; *(u32x4*)(zp + 64) = v2;
            }
        }
    }
}

namespace att {
constexpr int QBLK = 32, KVBLK = 64, NW = 8;
constexpr float SCALE = 0.088388347648318440f;
constexpr float THR = 8.f;
constexpr size_t SHM_V = KVBLK * 128 * 2, SHM_K = KVBLK * 128 * 2, SHM_ATTN = 2 * SHM_V + 2 * SHM_K + NW * 64 * 4;
constexpr int NT = 66;
#define KSWZ(row, colB) ((row) * 256 + ((colB) ^ (((row) & 7) << 4)))
#define SBAR() __builtin_amdgcn_sched_barrier(0)
__device__ __forceinline__ void partialSM(f32x16& p0, f32x16& p1, float& m_reg, float& mn, float& alpha) {
  constexpr float C = SCALE * 1.4426950408889634f;
  float pmax = p0[0]; for (int r = 1; r < 16; ++r) pmax = fmaxf(pmax, p0[r]); for (int r = 0; r < 16; ++r) pmax = fmaxf(pmax, p1[r]);
  { auto rr = __builtin_amdgcn_permlane32_swap(__float_as_uint(pmax), __float_as_uint(pmax), false, false);
    pmax = fmaxf(__uint_as_float(rr[0]), __uint_as_float(rr[1])); }
  if (__builtin_expect(__all(pmax - m_reg <= THR / SCALE), 1)) { mn = m_reg; alpha = 1.f; }
  else { mn = fmaxf(m_reg, pmax); alpha = __builtin_amdgcn_exp2f((m_reg - mn) * C); m_reg = mn; }
  float mnC = -mn * C;
  for (int r = 0; r < 16; ++r) p0[r] = fmaf(p0[r], C, mnC); for (int r = 0; r < 16; ++r) p1[r] = fmaf(p1[r], C, mnC);
  for (int r = 0; r < 16; ++r) p0[r] = __builtin_amdgcn_exp2f(p0[r]);
}
__device__ __forceinline__ void finishSM(f32x16& p0, f32x16& p1, float alpha, float& l_reg, bf16x8& pa0, bf16x8& pa1, bf16x8& pa2, bf16x8& pa3) {
  for (int r = 0; r < 16; ++r) p1[r] = __builtin_amdgcn_exp2f(p1[r]);
  float ps = 0; for (int r = 0; r < 16; ++r) ps += p0[r]; for (int r = 0; r < 16; ++r) ps += p1[r];
  { auto rr = __builtin_amdgcn_permlane32_swap(__float_as_uint(ps), __float_as_uint(ps), false, false);
    ps = __uint_as_float(rr[0]) + __uint_as_float(rr[1]); }
  l_reg = l_reg * alpha + ps;
#define PK4(P, BASE, OUT) do { unsigned a0 = pk2(P[BASE + 0], P[BASE + 1]), a1 = pk2(P[BASE + 2], P[BASE + 3]);   \
    unsigned b0 = pk2(P[BASE + 4], P[BASE + 5]), b1 = pk2(P[BASE + 6], P[BASE + 7]);                              \
    auto r0 = __builtin_amdgcn_permlane32_swap(a0, b0, false, false); auto r1 = __builtin_amdgcn_permlane32_swap(a1, b1, false, false); \
    u32x4 w = {r0[0], r1[0], r0[1], r1[1]}; OUT = *reinterpret_cast<bf16x8*>(&w); } while (0)
  PK4(p0, 0, pa0); PK4(p0, 8, pa1); PK4(p1, 0, pa2); PK4(p1, 8, pa3);
#undef PK4
}
__device__ __forceinline__ void qkt(f32x16& p0, f32x16& p1, const bf16_t* Ks, const bf16x8* qr, int r32, int hi) {
  p0 = f32x16{}; p1 = f32x16{};
  for (int d0 = 0; d0 < 8; ++d0) { int cb = (d0 * 16 + hi * 8) * 2;
    bf16x8 b0 = *reinterpret_cast<const bf16x8*>((const char*)Ks + KSWZ(r32, cb));
    bf16x8 b1 = *reinterpret_cast<const bf16x8*>((const char*)Ks + KSWZ(32 + r32, cb));
    p0 = mfma32(b0, qr[d0], p0);
    p1 = mfma32(b1, qr[d0], p1); }
}
__device__ __forceinline__ void kmask(f32x16& p0, f32x16& p1, int tile, int hi) {
  if (tile >= 64) {
    const int lim = tile == 64 ? 16 : 0;
#pragma unroll
    for (int r = 0; r < 16; ++r) { if (crow(r, hi) >= lim) p0[r] = -1e30f; p1[r] = -1e30f; }
  }
}
__device__ __forceinline__ int v_st(int k, int c) { const int kk = (k & ~0xC) | ((k & 4) << 1) | ((k & 8) >> 1); return ((kk >> 3) * 4 + (c >> 5)) * 512 + ((kk & 7) * 32 + (c & 31)) * 2; }
__device__ __forceinline__ int v_rd_base(int lane) { return ((lane & 3) << 3) | (((lane >> 2) & 3) << 6) | (((lane >> 4) & 1) << 5) | (((lane >> 5) & 1) << 8); }
constexpr int v_rd_off(int d0, int ks, int half) { return d0 * 512 + ks * 4096 + half * 2048; }
template <int OFF> __device__ __forceinline__ s16x4 tr_read(int vb) {
  s16x4 r; asm volatile("ds_read_b64_tr_b16 %0, %1 offset:%2" : "=&v"(r) : "v"(vb), "i"(OFF) : "memory"); return r;
}
template <int D0> __device__ __forceinline__ void pv_one(f32x16& od, int vb, bf16x8 pa0, bf16x8 pa1, bf16x8 pa2, bf16x8 pa3) {
  const s16x4 l0 = tr_read<v_rd_off(D0, 0, 0)>(vb), h0 = tr_read<v_rd_off(D0, 0, 1)>(vb), l1 = tr_read<v_rd_off(D0, 1, 0)>(vb), h1 = tr_read<v_rd_off(D0, 1, 1)>(vb);
  const s16x4 l2 = tr_read<v_rd_off(D0, 2, 0)>(vb), h2 = tr_read<v_rd_off(D0, 2, 1)>(vb), l3 = tr_read<v_rd_off(D0, 3, 0)>(vb), h3 = tr_read<v_rd_off(D0, 3, 1)>(vb);
  asm volatile("s_waitcnt lgkmcnt(0)" ::: "memory"); SBAR();
#define PK(L, H) (bf16x8){L[0], L[1], L[2], L[3], H[0], H[1], H[2], H[3]}
  od = mfma32(pa0, PK(l0, h0), od);
  od = mfma32(pa1, PK(l1, h1), od);
  od = mfma32(pa2, PK(l2, h2), od);
  od = mfma32(pa3, PK(l3, h3), od);
#undef PK
}
__device__ __forceinline__ void pv_d0(f32x16* o, int vb, bf16x8 pa0, bf16x8 pa1, bf16x8 pa2, bf16x8 pa3) {
  pv_one<0>(o[0], vb, pa0, pa1, pa2, pa3); pv_one<1>(o[1], vb, pa0, pa1, pa2, pa3); pv_one<2>(o[2], vb, pa0, pa1, pa2, pa3); pv_one<3>(o[3], vb, pa0, pa1, pa2, pa3);
}
__device__ __forceinline__ void attn_unit(const bf16_t* __restrict__ ZQ, bf16_t* __restrict__ Y, int b, int hsel, int qb, char* lds) {
  const int tid = otid(), wid = tid >> 6, lane = tid & 63, r32 = lane & 31, hi = lane >> 5;
  bf16_t* V_lds = (bf16_t*)lds; bf16_t* K_lds = (bf16_t*)(lds + 2 * SHM_V);
  float* ws = (float*)(lds + 2 * SHM_V + 2 * SHM_K) + wid * 64; float* li_l = ws; float* al_l = ws + 32;
  float m_reg = -1e30f, l_reg = 0; f32x16 o[4] = {}; bf16x8 qr[8];
  const bool meta = qb >= 16;
  const int h = meta ? hsel * 3 + (wid < 3 ? wid : 2) : hsel; const int kvh = meta ? hsel : hsel / 3;
  const long tb_real = (long)b * SEQ, tb_meta = (long)NREAL + 16 * b;
  { const long qrow = meta ? tb_meta + (r32 & 15) : tb_real + qb * 256 + wid * QBLK + r32;
    const bf16_t* Qw = ZQ + qrow * NQKV + h * 128 + hi * 8;
#pragma unroll
    for (int d0 = 0; d0 < 8; ++d0) qr[d0] = *reinterpret_cast<const bf16x8*>(Qw + d0 * 16); }
  const bf16_t* Kh = ZQ + 768 + kvh * 128; const bf16_t* Vh = ZQ + 1024 + kvh * 128;
  constexpr int LDK = NQKV;
  const int sr = tid >> 4, sc = (tid & 15) * 8, vst0 = v_st(sr, sc), vst1 = v_st(32 + sr, sc);
  const int vb0 = (int)(uintptr_t)V_lds + v_rd_base(lane);
  struct { bf16x8 vs0, vs1, ks0, ks1; } sr_[1];
#define SLOAD(i, t) do { const long k0_ = ((t) < 64 ? tb_real + 64 * (t) : tb_meta); sr_[i].vs0 = *reinterpret_cast<const bf16x8*>(&Vh[(k0_ + sr) * LDK + sc]); sr_[i].vs1 = *reinterpret_cast<const bf16x8*>(&Vh[(k0_ + 32 + sr) * LDK + sc]); \
    sr_[i].ks0 = *reinterpret_cast<const bf16x8*>(&Kh[(k0_ + sr) * LDK + sc]); sr_[i].ks1 = *reinterpret_cast<const bf16x8*>(&Kh[(k0_ + 32 + sr) * LDK + sc]); } while (0)
#define SWRITE(bb, i) do { *(bf16x8*)((char*)V_lds + (bb) * SHM_V + vst0) = sr_[i].vs0;          \
    *(bf16x8*)((char*)V_lds + (bb) * SHM_V + vst1) = sr_[i].vs1; int kc = sc * 2;               \
    *(bf16x8*)((char*)K_lds + (bb) * SHM_K + KSWZ(sr, kc)) = sr_[i].ks0;                       \
    *(bf16x8*)((char*)K_lds + (bb) * SHM_K + KSWZ(32 + sr, kc)) = sr_[i].ks1; } while (0)
#define SWAIT() asm volatile("s_waitcnt vmcnt(0)" ::: "memory")
#define RESC(a) do { if (__any((a) < 1.f)) { if (hi == 0) al_l[r32] = (a); asm volatile("s_waitcnt lgkmcnt(0)" ::: "memory"); \
    for (int d = 0; d < 4; ++d) for (int r = 0; r < 16; ++r) o[d][r] *= al_l[crow(r, hi)]; } } while (0)
  f32x16 pA0, pA1, pB0, pB1; float mnA, mnB, alA, alB; bf16x8 pa0, pa1, pa2, pa3;
  constexpr int SE = 0, SO = 0;
  SLOAD(SE, 0); asm volatile("s_waitcnt vmcnt(0)" ::: "memory"); SWRITE(0, SE); __syncthreads();
  qkt(pA0, pA1, K_lds, qr, r32, hi); partialSM(pA0, pA1, m_reg, mnA, alA);
  SLOAD(SO, 1);
  SWAIT(); SWRITE(1, SO); __syncthreads();
  for (int j = 1; j + 1 < NT; j += 2) {
    SBAR(); qkt(pB0, pB1, (bf16_t*)((char*)K_lds + SHM_K), qr, r32, hi); kmask(pB0, pB1, j, hi);
    finishSM(pA0, pA1, alA, l_reg, pa0, pa1, pa2, pa3); SBAR();
    SLOAD(SO, j + 1); SBAR();
    pv_d0(o, vb0, pa0, pa1, pa2, pa3); partialSM(pB0, pB1, m_reg, mnB, alB);
    __syncthreads(); SWAIT(); SWRITE(0, SE);
    RESC(alB); __syncthreads();
    SBAR(); qkt(pA0, pA1, K_lds, qr, r32, hi); kmask(pA0, pA1, j + 1, hi);
    finishSM(pB0, pB1, alB, l_reg, pa0, pa1, pa2, pa3); SBAR();
    SLOAD(SE, j + 2); SBAR();
    pv_d0(o, vb0 + (int)SHM_V, pa0, pa1, pa2, pa3); partialSM(pA0, pA1, m_reg, mnA, alA);
    __syncthreads(); SWAIT(); SWRITE(1, SO);
    RESC(alA); __syncthreads();
  }
  SBAR(); finishSM(pA0, pA1, alA, l_reg, pa0, pa1, pa2, pa3); SBAR();
  pv_d0(o, vb0, pa0, pa1, pa2, pa3);
  if (hi == 0) li_l[r32] = l_reg; asm volatile("s_waitcnt lgkmcnt(0)" ::: "memory");
  float rli[16];
#pragma unroll
  for (int r = 0; r < 16; ++r) rli[r] = __builtin_amdgcn_rcpf(li_l[crow(r, hi)]);
#pragma unroll
  for (int r = 0; r < 16; ++r) { const int ri = crow(r, hi);
    if (!meta || (wid < 3 && ri < 16)) { bf16_t* yp = Y + (meta ? tb_meta + ri : tb_real + qb * 256 + wid * QBLK + ri) * DM + 256 + h * 128 + r32;
#pragma unroll
      for (int d0 = 0; d0 < 4; ++d0) yp[d0 * 32] = f2b(o[d0][r] * rli[r]); } }
  __syncthreads();
#undef SLOAD
#undef SWRITE
#undef SWAIT
#undef RESC
}
}

#define LBAR() asm volatile("s_waitcnt lgkmcnt(0)\n\ts_barrier" ::: "memory")
__device__ __forceinline__ void scan_unit(const bf16_t* __restrict__ Z1, bf16_t* __restrict__ OUT, int b, int h, int dir, int vs, unsigned char* lds, int dry = 0) {
    const int tid = otid(), wid = tid >> 6, lane = tid & 63, r32 = lane & 31, hi = lane >> 5;
    float* TOT = (float*)(lds); float* DVv = (float*)(lds + 4096);
    bf16_t* QT = (bf16_t*)(lds + 4608); bf16_t* KT = (bf16_t*)(lds + 22016); bf16_t* QI = (bf16_t*)(lds + 39424); bf16_t* KHT = (bf16_t*)(lds + 56832);
    bf16_t* VT = (bf16_t*)(lds + 75264); bf16_t* AS = (bf16_t*)(lds + 84480); bf16_t* SB = (bf16_t*)(lds + 93696);
    const int cp = tid & 63, seg = __builtin_amdgcn_readfirstlane(tid >> 6);
    const int vp = tid & 31, tgv = tid >> 5;
    const bf16_t* Qg = Z1 + h * 128 + 2 * cp; const bf16_t* Gg = Z1 + 1024 + dir * 1024 + h * 128 + 2 * cp; const bf16_t* Vg = Z1 + 3072 + h * 128 + vs * 64 + 2 * vp;
    f32x16 Sacc = {}; f32x16 oacc = {};
    for (int i = tid; i < 17408 / 4; i += 512) ((unsigned*)SB)[i] = 0u;
    int cur = 0;
    unsigned rq[8], rk[8], rv[4];
#define LOADC(cc) do { const int c_ = (cc); const long tk_ = c_ ? (long)b * SEQ + 64 * (c_ - 1) : (long)NREAL + 16 * b; \
    if (c_ != 0 || seg < 2) { const bf16_t* qp_ = Qg + (size_t)(tk_ + 8 * seg) * NC; const bf16_t* gp_ = Gg + (size_t)(tk_ + 8 * seg) * NC; \
        _Pragma("unroll") for (int i_ = 0; i_ < 8; ++i_) { rq[i_] = *(const unsigned*)qp_; rk[i_] = *(const unsigned*)gp_; qp_ += NC; gp_ += NC; } } \
    else { _Pragma("unroll") for (int i_ = 0; i_ < 8; ++i_) { rq[i_] = 0u; rk[i_] = 0u; } } \
    if (c_ != 0 || tgv < 4) { const bf16_t* vp_ = Vg + (size_t)(tk_ + 4 * tgv) * NC; \
        _Pragma("unroll") for (int i_ = 0; i_ < 4; ++i_) { rv[i_] = *(const unsigned*)vp_; vp_ += NC; } } \
    else { _Pragma("unroll") for (int i_ = 0; i_ < 4; ++i_) rv[i_] = 0u; } } while (0)
    LOADC(dir ? 64 : 0);
#pragma nounroll
    for (int step = 0; step < 65; ++step) {
        const int c = dir ? 64 - step : step;
        const long tok0 = c ? (long)b * SEQ + 64 * (c - 1) : (long)NREAL + 16 * b; const int nvalid = c ? 64 : 16;
        float ka[8], kb[8], pa[8], pb[8];
#pragma unroll
        for (int i = 0; i < 8; ++i) { ka[i] = blo(rk[i]); kb[i] = bhi(rk[i]); }
        { float xa = 1.f, xb = 1.f;
          if (dir == 0) {
#pragma unroll
              for (int i = 0; i < 8; ++i) { xa *= 1.0f - ka[i]; xb *= 1.0f - kb[i]; pa[i] = xa; pb[i] = xb; } }
          else {
#pragma unroll
              for (int i = 7; i >= 0; --i) { xa *= 1.0f - ka[i]; xb *= 1.0f - kb[i]; pa[i] = xa; pb[i] = xb; } }
          *(f32x2*)(TOT + seg * 128 + 2 * cp) = (f32x2){xa, xb}; }
        LBAR();
        {
            f32x2 Ts[8];
#pragma unroll
            for (int s_ = 0; s_ < 8; ++s_) Ts[s_] = *(const f32x2*)(TOT + s_ * 128 + 2 * cp);
            const f32x2 lo4 = (Ts[0] * Ts[1]) * (Ts[2] * Ts[3]), hi4 = (Ts[4] * Ts[5]) * (Ts[6] * Ts[7]);
            const f32x2 one = {1.f, 1.f};
            f32x2 cs, eref, erest;
            if (dir == 0) {
                eref = lo4; erest = hi4;
                if (seg <= 3) { f32x2 m = one;
#pragma unroll
                    for (int s_ = 0; s_ < 4; ++s_) m = m * (s_ >= seg ? Ts[s_] : one);
                    cs.x = __builtin_amdgcn_rcpf(m.x); cs.y = __builtin_amdgcn_rcpf(m.y); }
                else { f32x2 m = one;
#pragma unroll
                    for (int s_ = 4; s_ < 7; ++s_) m = m * (s_ < seg ? Ts[s_] : one);
                    cs = m; }
            } else {
                eref = hi4; erest = lo4;
                if (seg >= 4) { f32x2 m = one;
#pragma unroll
                    for (int s_ = 4; s_ < 8; ++s_) m = m * (s_ <= seg ? Ts[s_] : one);
                    cs.x = __builtin_amdgcn_rcpf(m.x); cs.y = __builtin_amdgcn_rcpf(m.y); }
                else { f32x2 m = one;
#pragma unroll
                    for (int s_ = 1; s_ < 4; ++s_) m = m * (s_ > seg ? Ts[s_] : one);
                    cs = m; }
            }
            float kha[8], khb[8];
#pragma unroll
            for (int i = 0; i < 8; ++i) {
                const float Ra = pa[i] * cs.x, Rb = pb[i] * cs.y;
                const float qa = blo(rq[i]), qb_ = bhi(rq[i]);
                const float ia = __builtin_amdgcn_rcpf(Ra), ib = __builtin_amdgcn_rcpf(Rb);
                const float qra = qa * Ra, qrb = qb_ * Rb, kia = ka[i] * ia, kib = kb[i] * ib;
                const int o_ = (8 * seg + i) * 136 + 2 * cp;
                *(unsigned*)(QT + o_) = pk2_bf(qra, qrb);
                *(unsigned*)(QI + o_) = pk2(qra * eref.x, qrb * eref.y);
                *(unsigned*)(KT + o_) = pk2_bf(kia, kib);
                kha[i] = kia * erest.x; khb[i] = kib * erest.y;
            }
            u32x4 w0, w1;
            w0.x = pk2(kha[0], kha[1]); w0.y = pk2(kha[2], kha[3]); w0.z = pk2(kha[4], kha[5]); w0.w = pk2(kha[6], kha[7]);
            w1.x = pk2(khb[0], khb[1]); w1.y = pk2(khb[2], khb[3]); w1.z = pk2(khb[4], khb[5]); w1.w = pk2(khb[6], khb[7]);
            *(u32x4*)(KHT + (2 * cp) * 72 + 8 * seg) = w0; *(u32x4*)(KHT + (2 * cp + 1) * 72 + 8 * seg) = w1;
            if (seg == 0) *(f32x2*)(DVv + 2 * cp) = lo4 * hi4;
            u32x2 va, vb;
            va.x = (rv[0] & 0xffffu) | (rv[1] << 16); va.y = (rv[2] & 0xffffu) | (rv[3] << 16);
            vb.x = (rv[0] >> 16) | (rv[1] & 0xffff0000u); vb.y = (rv[2] >> 16) | (rv[3] & 0xffff0000u);
            *(u32x2*)(VT + (2 * vp) * 72 + 4 * tgv) = va; *(u32x2*)(VT + (2 * vp + 1) * 72 + 4 * tgv) = vb;
        }
        if (step + 1 < 65 && !(dry & 2)) LOADC(dir ? 63 - step : step + 1);
        LBAR();
        if (wid < 4) {
            const int a = wid >> 1, sb = wid & 1;
            f32x16 p = {};
            const bf16_t* kp = KT + (32 * sb + r32) * 136 + 8 * hi; const bf16_t* qp = QT + (32 * a + r32) * 136 + 8 * hi;
#pragma unroll
            for (int kk = 0; kk < 8; ++kk) p = __builtin_amdgcn_mfma_f32_32x32x16_bf16(*(const bf16x8*)(kp + 16 * kk), *(const bf16x8*)(qp + 16 * kk), p, 0, 0, 0);
            const int t = 32 * a + r32;
#pragma unroll
            for (int r4 = 0; r4 < 4; ++r4) {
                const int s0 = 32 * sb + 8 * r4 + 4 * hi; float v[4];
#pragma unroll
                for (int e = 0; e < 4; ++e) { const int s_ = s0 + e; const bool keep = dir == 0 ? (s_ <= t) : (s_ >= t); v[e] = keep ? p[4 * r4 + e] : 0.f; }
                u32x2 w; w.x = pk2(v[0], v[1]); w.y = pk2(v[2], v[3]);
                *(u32x2*)(AS + t * 72 + s0) = w;
            }
        } else {
            const int a = (wid - 4) >> 1, j = (wid - 4) & 1;
            oacc = f32x16{};
            const bf16_t* qp = QI + (32 * a + r32) * 136 + 8 * hi; const bf16_t* sp = SB + cur * 8704 + (32 * j + r32) * 136 + 8 * hi;
#pragma unroll
            for (int kk = 0; kk < 8; ++kk) oacc = mfma32(*(const bf16x8*)(qp + 16 * kk), *(const bf16x8*)(sp + 16 * kk), oacc);
        }
        {
            const int i = wid >> 1, j = wid & 1;
#pragma unroll
            for (int r = 0; r < 16; ++r) Sacc[r] *= DVv[32 * i + crow(r, hi)];
            const bf16_t* ap = KHT + (32 * i + r32) * 72 + 8 * hi; const bf16_t* vp = VT + (32 * j + r32) * 72 + 8 * hi;
#pragma unroll
            for (int kk = 0; kk < 4; ++kk) Sacc = mfma32(*(const bf16x8*)(ap + 16 * kk), *(const bf16x8*)(vp + 16 * kk), Sacc);
            bf16_t* sbn = SB + (cur ^ 1) * 8704 + (32 * j + r32) * 136 + 32 * i + 4 * hi;
#pragma unroll
            for (int r4 = 0; r4 < 4; ++r4) { u32x2 w; w.x = pk2(Sacc[4 * r4], Sacc[4 * r4 + 1]); w.y = pk2(Sacc[4 * r4 + 2], Sacc[4 * r4 + 3]); *(u32x2*)(sbn + 8 * r4) = w; }
        }
        LBAR();
        if (wid >= 4) {
            const int a = (wid - 4) >> 1, j = (wid - 4) & 1;
            const bf16_t* ap = AS + (32 * a + r32) * 72 + 8 * hi; const bf16_t* vp = VT + (32 * j + r32) * 72 + 8 * hi;
#pragma unroll
            for (int kk = 0; kk < 4; ++kk) oacc = mfma32(*(const bf16x8*)(ap + 16 * kk), *(const bf16x8*)(vp + 16 * kk), oacc);
            bf16_t* ost = QT + (wid - 4) * 1280;
#pragma unroll
            for (int r = 0; r < 16; ++r) ost[crow(r, hi) * 40 + r32] = f2b(oacc[r]);
            asm volatile("s_waitcnt lgkmcnt(0)" ::: "memory");
#pragma unroll
            for (int i = 0; i < 2; ++i) {
                const int pc = lane + 64 * i, row = pc >> 2, sg = pc & 3;
                const u32x4 w = *(const u32x4*)(ost + row * 40 + sg * 8);
                if (32 * a + row < nvalid && !(dry & 1)) *(u32x4*)(OUT + (size_t)(tok0 + 32 * a + row) * DM + h * 128 + vs * 64 + 32 * j + sg * 8) = w;
            }
        }
        cur ^= 1;
    }
    __syncthreads();
#undef LOADC
}

__device__ __forceinline__ void hgrn_finalize(const Params& P, int dry = 0) {
    const int tid = otid(), lane = tid & 63, wid = tid >> 6;
    const bf16_t* O = (const bf16_t*)P.out; const bf16_t* Z1 = (const bf16_t*)(P.ws + WS_Z1); bf16_t* Y = (bf16_t*)(P.ws + WS_Y);
    const int col = (lane >> 3) * 128 + (lane & 7) * 16;
    float og[16];
#pragma unroll
    for (int e = 0; e < 16; ++e) og[e] = P.c_o_gain[col + e];
    const int nw = gridDim.x * 8, w0 = blockIdx.x * 8 + wid;
    for (int row = w0; row < T; row += 2 * nw) {
        const int rowb = row + nw; const bool hasb = rowb < T; const int rb = hasb ? rowb : row;
        u32x4 oa[2], ya[2], ga[2], ob[2], yb[2], gb[2];
#pragma unroll
        for (int i = 0; i < 2; ++i) {
            oa[i] = *(const u32x4*)(O + (size_t)row * DM + col + 8 * i); ya[i] = *(const u32x4*)(Y + (size_t)row * DM + col + 8 * i); ga[i] = *(const u32x4*)(Z1 + (size_t)row * NC + 4096 + col + 8 * i);
            ob[i] = *(const u32x4*)(O + (size_t)rb * DM + col + 8 * i); yb[i] = *(const u32x4*)(Y + (size_t)rb * DM + col + 8 * i); gb[i] = *(const u32x4*)(Z1 + (size_t)rb * NC + 4096 + col + 8 * i);
        }
#pragma unroll
        for (int it = 0; it < 2; ++it) {
            float o[16], g[16];
#pragma unroll
            for (int i = 0; i < 2; ++i) {
                const u32x4 ow = it ? ob[i] : oa[i], yw = it ? yb[i] : ya[i], gw = it ? gb[i] : ga[i];
                o[8 * i + 0] = blo(ow.x) + blo(yw.x); o[8 * i + 1] = bhi(ow.x) + bhi(yw.x); o[8 * i + 2] = blo(ow.y) + blo(yw.y); o[8 * i + 3] = bhi(ow.y) + bhi(yw.y);
                o[8 * i + 4] = blo(ow.z) + blo(yw.z); o[8 * i + 5] = bhi(ow.z) + bhi(yw.z); o[8 * i + 6] = blo(ow.w) + blo(yw.w); o[8 * i + 7] = bhi(ow.w) + bhi(yw.w);
                g[8 * i + 0] = blo(gw.x); g[8 * i + 1] = bhi(gw.x); g[8 * i + 2] = blo(gw.y); g[8 * i + 3] = bhi(gw.y); g[8 * i + 4] = blo(gw.z); g[8 * i + 5] = bhi(gw.z); g[8 * i + 6] = blo(gw.w); g[8 * i + 7] = bhi(gw.w);
            }
            float ss = 0.f;
#pragma unroll
            for (int e = 0; e < 16; ++e) ss += o[e] * o[e];
            ss += __shfl_xor(ss, 1); ss += __shfl_xor(ss, 2); ss += __shfl_xor(ss, 4);
            const float rs = rsqrtf(ss * (1.0f / 128.0f) + EPS);
            if (!dry && (it == 0 || hasb)) {
                bf16_t* yp = Y + (size_t)(it ? rb : row) * DM + col;
#pragma unroll
                for (int i = 0; i < 2; ++i) {
                    u32x4 w;
                    w.x = pk2(o[8 * i + 0] * rs * og[8 * i + 0] * g[8 * i + 0], o[8 * i + 1] * rs * og[8 * i + 1] * g[8 * i + 1]);
                    w.y = pk2(o[8 * i + 2] * rs * og[8 * i + 2] * g[8 * i + 2], o[8 * i + 3] * rs * og[8 * i + 3] * g[8 * i + 3]);
                    w.z = pk2(o[8 * i + 4] * rs * og[8 * i + 4] * g[8 * i + 4], o[8 * i + 5] * rs * og[8 * i + 5] * g[8 * i + 5]);
                    w.w = pk2(o[8 * i + 6] * rs * og[8 * i + 6] * g[8 * i + 6], o[8 * i + 7] * rs * og[8 * i + 7] * g[8 * i + 7]);
                    *(u32x4*)(yp + 8 * i) = w;
                }
            }
        }
    }
}

__device__ __forceinline__ void fast_barrier(unsigned* bar, unsigned gen) {
    asm volatile("s_waitcnt vmcnt(0) lgkmcnt(0)" ::: "memory");
    __syncthreads();
    if (threadIdx.x == 0) {
        const unsigned g = blockIdx.x >> 5, ng = (gridDim.x + 31) >> 5;
        const unsigned gsz = (g + 1) * 32 <= gridDim.x ? 32u : gridDim.x - g * 32;
        __builtin_amdgcn_fence(__ATOMIC_RELEASE, "agent");
        asm volatile("s_waitcnt vmcnt(0)" ::: "memory");
        if (__hip_atomic_fetch_add(bar + 64 * g, 1u, __ATOMIC_RELAXED, __HIP_MEMORY_SCOPE_AGENT) + 1u == gsz * gen) {
            if (__hip_atomic_fetch_add(bar + 512, 1u, __ATOMIC_RELAXED, __HIP_MEMORY_SCOPE_AGENT) + 1u == ng * gen) {
                for (unsigned i = 0; i < ng; ++i) __hip_atomic_store(bar + 1024 + 64 * i, gen, __ATOMIC_RELAXED, __HIP_MEMORY_SCOPE_AGENT);
            }
        }
        while (__hip_atomic_load(bar + 1024 + 64 * g, __ATOMIC_RELAXED, __HIP_MEMORY_SCOPE_AGENT) < gen) __builtin_amdgcn_s_sleep(1);
        __builtin_amdgcn_fence(__ATOMIC_ACQUIRE, "agent");
        asm volatile("s_waitcnt vmcnt(0)" ::: "memory");
    }
    __syncthreads();
}
#ifdef REP_SYNC
#define GSYNC() do { ++nbar; fast_barrier(barw, nbar); ++nbar; fast_barrier(barw, nbar); } while (0)
#else
#define GSYNC() do { ++nbar; fast_barrier(barw, nbar); } while (0)
#endif
__global__ void __launch_bounds__(512) fwd_megakernel(Params P) {
    extern __shared__ __attribute__((aligned(16))) unsigned char lds[];
    cg::grid_group grid = cg::this_grid();
    PG8_LAS unsigned char* lds3 = (PG8_LAS unsigned char*)lds;
    unsigned char* ws = P.ws;
    const int G = gridDim.x, bx = blockIdx.x;
    float* rowss = (float*)(ws + WS_ROWSS);
    bf16_t* HB = (bf16_t*)(ws + WS_HB); bf16_t* Y = (bf16_t*)(ws + WS_Y);
    unsigned* barw = (unsigned*)(ws + WS_BAR); unsigned nbar = 0;

#ifndef REP_P0
#define REP_P0 1
#endif
#ifndef REP_ATTN
#define REP_ATTN 1
#endif
#ifndef REP_SCAN
#define REP_SCAN 1
#endif
#ifndef REP_FOUR
#define REP_FOUR 1
#endif
#ifndef REP_UP
#define REP_UP 1
#endif
#ifndef REP_META
#define REP_META 1
#endif
#ifndef REP_IN
#define REP_IN 1
#endif
#ifndef REP_HG
#define REP_HG 1
#endif
#ifndef SCAN_DRY
#define SCAN_DRY 0
#endif
#pragma nounroll
    for (int rep = 0; rep < REP_P0; ++rep) { p0_prologue(P, lds); if (rep + 1 < REP_P0) GSYNC(); }
    asm volatile("s_waitcnt vmcnt(0)" ::: "memory"); grid.sync();

#pragma nounroll
    for (int layer = 0; layer < 2; ++layer) {
        if (layer == 0) {
            { pg8::Gemm g{(const bf16_t*)(ws + W_UCS), HB, 512, TP, DM}; pg8::StaticOrder S; S.init(512, TP, G, bx);
              EpiUcs E{(bf16_t*)(ws + WS_UCST), rowss};
#ifndef NO_G_UCS
              for (int rep = 0; rep < REP_IN; ++rep)
              pg8::gemm_phase<EpiUcs, pg8::StaticOrder, true, true>(lds3, g, S, E);
#endif
            }
            { pg8::Gemm g{HB, (const bf16_t*)(ws + W_QKV), TP, NQKV, DM}; pg8::StaticOrder S; S.init(TP, NQKV, G, G - 1 - bx);
              EpiAct<0> E{(bf16_t*)(ws + WS_ZQ), NQKV, rowss};
#ifndef NO_G_A0
              for (int rep = 0; rep < REP_IN; ++rep)
              pg8::gemm_phase<EpiAct<0>, pg8::StaticOrder, true, true>(lds3, g, S, E);
#endif
            }
            if (bx >= 2 && bx < 123) gen_adft(P, bx - 2, 121);
            GSYNC();
#ifdef REP_EW
            qk_norm_rope(P, (int)(P.c_lb != nullptr));
#endif
            qk_norm_rope(P);
            GSYNC();
#pragma nounroll
            for (int rep = 0; rep < REP_ATTN; ++rep)
            for (int u = bx; u < NB * 6 * 16 + 16; u += G) {
                int b, h, qb;
                if (u < NB * 96) { b = bx & 7; const int ul = (bx >> 3) + 32 * (u >> 8); h = ul >> 4; qb = ul & 15; } else { const int m = u - NB * 96; b = m & 7; h = m >> 3; qb = 16; }
#ifndef NO_ATTN
                att::attn_unit((const bf16_t*)(ws + WS_ZQ), Y, b, h, qb, (char*)lds);
#endif
            }
            if (bx >= 152) weight_jobs(P, lds, 1, 8, bx - 152, G - 152);
            { pg8::Gemm g{(const bf16_t*)(ws + WS_ADFT), (const bf16_t*)(ws + WS_UCST), MF, 2048, KF}; pg8::StaticOrder S; S.init(MF, 2048, 136, bx - 16);
              EpiFour E{Y};
#ifndef NO_G_FOUR
              if (bx >= 16 && bx < 152)
#pragma nounroll
              for (int rep = 0; rep < REP_FOUR; ++rep)
              pg8::gemm_phase<EpiFour, pg8::StaticOrder, true, true>(lds3, g, S, E);
#endif
            }
            GSYNC();
        } else {
            { pg8::Gemm g{HB, (const bf16_t*)(ws + W_C), NREAL, NC, DM}; pg8::StaticOrder S; S.init(NREAL, NC, G, bx);
              EpiHgrn E{(bf16_t*)(ws + WS_Z1), rowss + 2 * (size_t)TP, (const float*)(ws + WS_LB)};
#ifndef NO_G_HGRN
              for (int rep = 0; rep < REP_HG; ++rep)
              pg8::gemm_phase<EpiHgrn, pg8::StaticOrder, true, true>(lds3, g, S, E);
#endif
            }
            { MetaHgrn E{(bf16_t*)(ws + WS_Z1), rowss + 2 * (size_t)TP, (const float*)(ws + WS_LB)};
              for (int rep = 0; rep < REP_META; ++rep) meta_gemm(HB + (size_t)NREAL * DM, DM, (const bf16_t*)(ws + W_C), DM, NC, E, lds); }
            GSYNC();
#pragma nounroll
            for (int rep = 0; rep < REP_SCAN; ++rep)
            for (int u = bx; u < NB * 8 * 4; u += G) {
                const int slot = u >> 3, grp = (u & 7) * 8 + (slot >> 2); const int b = grp >> 3, h = grp & 7, vs = (slot >> 1) & 1, dir = slot & 1;
#ifndef NO_SCAN
                scan_unit((const bf16_t*)(ws + WS_Z1), dir ? Y : (bf16_t*)P.out, b, h, dir, vs, lds, rep + 1 < REP_SCAN ? SCAN_DRY : 0);
#endif
            }
            GSYNC();
#if defined(STOP_AT) && STOP_AT == 5
            { const int tid = otid(); for (long i = (long)bx * 512 + tid; i < (long)NB * SEQ * DM; i += (long)G * 512) P.out[i] = b2f(HB[i]); return; }
#endif
#ifdef REP_EW
            hgrn_finalize(P, (int)(P.c_lb != nullptr));
#endif
            hgrn_finalize(P);
            GSYNC();
#if defined(STOP_AT) && STOP_AT == 6
            { const int tid = otid(); for (long i = (long)bx * 512 + tid; i < (long)NB * SEQ * DM; i += (long)G * 512) P.out[i] = b2f(Y[i]); return; }
#endif
        }
#if defined(STOP_AT) && STOP_AT == 1
        if (layer == 0) return;
#endif
#if defined(STOP_AT) && STOP_AT == 4
        if (layer == 1) return;
#endif
        int bxl = bx, Gl = G; asm volatile("" : "+s"(bxl), "+s"(Gl));
        const int MG = NREAL;
        { pg8::Gemm g{Y, (const bf16_t*)(ws + W_O0 + (size_t)layer * 2 * MiB), MG, DM, DM}; pg8::StaticOrder S; S.init(MG, DM, Gl, bxl);
          EpiRes E{HB, rowss + (size_t)(1 + 2 * layer) * TP};
#ifndef NO_G_RES
          pg8::gemm_phase<EpiRes, pg8::StaticOrder, true, true>(lds3, g, S, E);
#endif
            }
        if (layer == 0) { MetaRes E{HB, rowss + (size_t)TP}; meta_gemm(Y + (size_t)NREAL * DM, DM, (const bf16_t*)(ws + W_O0), DM, DM, E, lds); }
        GSYNC();
#if defined(STOP_AT) && STOP_AT == 2
        if (layer == 0) return;
#endif
        { pg8::Gemm g{HB, (const bf16_t*)(ws + W_1_0 + (size_t)layer * 8 * MiB), MG, DFF, DM}; pg8::StaticOrder S; S.init(MG, DFF, Gl, bxl);
          EpiAct<1> E{(bf16_t*)(ws + WS_HID), DFF, rowss + (size_t)(1 + 2 * layer) * TP};
#ifndef NO_G_A1
#pragma nounroll
          for (int rep = 0; rep < REP_UP; ++rep)
          pg8::gemm_phase<EpiAct<1>, pg8::StaticOrder, true, true>(lds3, g, S, E);
#endif
            }
        if (layer == 0) { MetaUp E{(bf16_t*)(ws + WS_HID), rowss + (size_t)TP}; for (int rep = 0; rep < REP_META; ++rep) meta_gemm(HB + (size_t)NREAL * DM, DM, (const bf16_t*)(ws + W_1_0), DM, DFF, E, lds); }
        GSYNC();
        { pg8::Gemm g{(const bf16_t*)(ws + WS_HID), (const bf16_t*)(ws + W_2_0 + (size_t)layer * 8 * MiB), MG, DM, DFF}; pg8::StaticOrder S; S.init(MG, DM, Gl, bxl);
          EpiRes E{HB, rowss + (size_t)(2 + 2 * layer) * TP};
#ifdef REP_DOWN
          { EpiDummy ED{(float*)P.c_lb == nullptr ? (float*)(ws + WS_Y) : nullptr}; pg8::gemm_phase<EpiDummy, pg8::StaticOrder, true, true>(lds3, g, S, ED); }
#endif
#ifndef NO_G_RES
          pg8::gemm_phase<EpiRes, pg8::StaticOrder, true, true>(lds3, g, S, E);
#endif
            }
        if (layer == 0) { MetaRes E{HB, rowss + 2 * (size_t)TP}; meta_gemm((const bf16_t*)(ws + WS_HID) + (size_t)NREAL * DFF, DFF, (const bf16_t*)(ws + W_2_0), DFF, DM, E, lds); }
        GSYNC();
#if defined(STOP_AT) && STOP_AT == 3
        if (layer == 0) return;
#endif
    }
    const int tid = otid(), lane = tid & 63, wid = tid >> 6;
#ifdef REP_EW
    for (int rep = 0; rep < 2; ++rep)
#endif
    for (int orow = bx * 8 + wid; orow < NB * SEQ; orow += G * 8) {
        const float rs = rstd_of(rowss[(size_t)4 * TP + orow]);
        float* hp = P.out + (size_t)orow * DM; const bf16_t* hb = HB + (size_t)orow * DM;
#pragma unroll
        for (int i = 0; i < 4; ++i) {
            const int col = i * 256 + lane * 4;
            const u32x2 hw = *(const u32x2*)(hb + col); const f32x4 g = *(const f32x4*)(P.final_gain + col);
            const f32x4 v = {blo(hw.x), bhi(hw.x), blo(hw.y), bhi(hw.y)};
            *(f32x4*)(hp + col) = v * rs * g;
        }
    }
}

extern "C" void kernel_launch(void* const* d_in, const int* in_sizes, int n_in, void* d_out, int out_size, void* d_ws, size_t ws_size, hipStream_t stream) {
    static int grid_blocks = 0;
    if (grid_blocks == 0) {
        if (n_in != 15 || out_size != NB * SEQ * DM || ws_size < WS_NEED) { fprintf(stderr, "kernel_launch: unexpected shapes (n_in %d out %d ws %zu, need %zu)\n", n_in, out_size, ws_size, (size_t)WS_NEED); grid_blocks = -1; return; }
        int dev = 0, cus = 0, per_cu = 0;
        hipGetDevice(&dev);
        hipDeviceGetAttribute(&cus, hipDeviceAttributeMultiprocessorCount, dev);
        if (hipFuncSetAttribute((const void*)fwd_megakernel, hipFuncAttributeMaxDynamicSharedMemorySize, LDS_BYTES) != hipSuccess) { fprintf(stderr, "kernel_launch: hipFuncSetAttribute failed\n"); grid_blocks = -1; return; }
        if (hipOccupancyMaxActiveBlocksPerMultiprocessor(&per_cu, (const void*)fwd_megakernel, 512, LDS_BYTES) != hipSuccess || per_cu < 1) { fprintf(stderr, "kernel_launch: occupancy query gave %d\n", per_cu); per_cu = 1; }
        (void)hipGetLastError();
        if (cus < 256) { fprintf(stderr, "kernel_launch: needs 256 CUs, found %d\n", cus); grid_blocks = -1; return; }
        grid_blocks = 256;
    }
    if (grid_blocks < 0) return;
    Params p{};
    p.x = (const float*)d_in[0]; p.meta = (const float*)d_in[1]; p.mix_gain = (const float*)d_in[2]; p.ab_w_in = (const float*)d_in[3];
    p.ab_q_gain = (const float*)d_in[4]; p.ab_k_gain = (const float*)d_in[5]; p.ab_w_out = (const float*)d_in[6]; p.c_w_in = (const float*)d_in[7];
    p.c_lb = (const float*)d_in[8]; p.c_o_gain = (const float*)d_in[9]; p.c_w_out = (const float*)d_in[10]; p.mlp_gain = (const float*)d_in[11];
    p.mlp_w1 = (const float*)d_in[12]; p.mlp_w2 = (const float*)d_in[13]; p.final_gain = (const float*)d_in[14];
    p.out = (float*)d_out; p.ws = (unsigned char*)d_ws;
    if (hipMemsetAsync((char*)d_ws + WS_BAR, 0, 8192, stream) != hipSuccess) { fprintf(stderr, "kernel_launch: memset failed\n"); return; }
    void* args[] = {&p};
    hipError_t e = hipLaunchCooperativeKernel((const void*)fwd_megakernel, dim3(grid_blocks), dim3(512), args, LDS_BYTES, stream);
    if (e != hipSuccess) fprintf(stderr, "kernel_launch: cooperative launch failed: %s (grid %d)\n", hipGetErrorString(e), grid_blocks);
}
```

```cpp
#include <hip/hip_runtime.h>
#include <hip/hip_cooperative_groups.h>
#include <hip/hip_bf16.h>
#include <cstdio>
#include <cstdint>
namespace cg = cooperative_groups;
namespace pg8 {
#define PG8_LAS __attribute__((address_space(3)))
typedef unsigned short bf16_t;
typedef short bf16x8 __attribute__((ext_vector_type(8)));
typedef _Float16 f16x8 __attribute__((ext_vector_type(8)));
typedef float f32x4 __attribute__((ext_vector_type(4)));
typedef unsigned u32x4 __attribute__((ext_vector_type(4)));
constexpr int BM = 256, BK = 64, HALF = 128, HTB = HALF * BK * 2  , STAGE_BYTES = 8 * HTB, NXCD = 8, WGM = 4;

__host__ __device__ __forceinline__ int lds_byte(int r, int c) { const int st = (r >> 4) * 2 + (c >> 5), rr = r & 15, cc = c & 31, ob = rr * 64 + cc * 2; return st * 1024 + (ob ^ (((ob >> 9) & 1) << 5)); }
__host__ __device__ __forceinline__ void stage_rc(int b, int& R, int& C) { const int st = b / 1024, sb = b % 1024, swz = sb ^ (((sb >> 9) & 1) << 5); R = (st >> 1) * 16 + swz / 64; C = (st & 1) * 32 + (swz % 64) / 2; }
__host__ __device__ __forceinline__ int perm32(int rho) { const int n = rho >> 4, i = rho & 15; return 8 * (i >> 2) + 4 * n + (i & 3); }

struct Unit { int pm, pn; };
struct Gemm { const bf16_t* A; const bf16_t* Bt; int M, N, K; };

struct StaticOrder {
    int nM, nN, nwg, G, c;
    __host__ __device__ void init(int M, int N, int G_, int c_) { nM = M / BM; nN = N / BM; nwg = nM * nN; G = G_; c = c_; }
    __host__ __device__ bool next(int i, Unit& u) const {
        const long L = (long)i * G + c; if (L >= nwg) return false;
        int wgid = (int)L; { const int q = nwg / NXCD, r = nwg % NXCD, xcd = wgid % NXCD, off = wgid / NXCD; wgid = (xcd < r ? xcd * (q + 1) : r * (q + 1) + (xcd - r) * q) + off; }
        const int nig = WGM * nN, gid = wgid / nig, fm = gid * WGM, gsz = (nM - fm) < WGM ? (nM - fm) : WGM;
        u.pm = fm + ((wgid % nig) % gsz); u.pn = (wgid % nig) / gsz; return true;
    }
    __device__ __forceinline__ void a_ready(const Unit&) const {}
    __device__ __forceinline__ void done(const Unit&) const {}
};

__device__ __forceinline__ unsigned cvt_pk_bf16(float lo, float hi) { unsigned r; asm volatile("v_cvt_pk_bf16_f32 %0, %1, %2" : "=v"(r) : "v"(lo), "v"(hi)); return r; }
typedef float f32x2 __attribute__((ext_vector_type(2)));
template <class Epi, class Sched, bool ALIGN_EPI = false, bool SP2 = false>
__device__ __forceinline__ void gemm_phase(PG8_LAS unsigned char* lds, const Gemm g, const Sched& S, const Epi& E) {
    int tid_o = threadIdx.x; asm volatile("" : "+v"(tid_o));
    const int tid = tid_o, wid = __builtin_amdgcn_readfirstlane(tid >> 6), lane = tid & 63, wr = wid >> 2, wc = wid & 3, fr = lane & 15, fq = lane >> 4;
    const int K = g.K, nt = K / BK;
    unsigned voffA[2], voffB[2];
#pragma unroll
    for (int i = 0; i < 2; ++i) { int R, C; stage_rc(tid * 16 + i * 8192, R, C); const int Rb = Epi::PERM ? ((R & ~31) + perm32(R & 31)) : R;
        voffA[i] = (unsigned)(R * K + C) * 2u; voffB[i] = (unsigned)(Rb * K + C) * 2u; }
    const size_t kstep = (size_t)(BK * 2);
    const size_t hstep = (size_t)HALF * K * 2;
    const size_t tstep = 2 * hstep;
    const unsigned ldsw = (unsigned)wid * 1024u;
    const int aoff = lds_byte(wr * 64 + fr, fq * 8), boff = lds_byte(wc * 32 + fr, fq * 8);
#define PG8_SA(b, h) (((b) * 2 + (h)) * HTB)
#define PG8_SB(b, h) ((4 + (b) * 2 + (h)) * HTB)
#define PG8_STAGE(bufoff, gbase, voff) do { _Pragma("unroll") for (int _i = 0; _i < 2; ++_i) \
        __builtin_amdgcn_global_load_lds((const unsigned*)((const char*)(gbase) + (voff)[_i]), (PG8_LAS unsigned*)(lds + (bufoff) + ldsw + _i * 8192), 16, 0, 0); } while (0)
#define PG8_LDA(dst, b, h) do { _Pragma("unroll") for (int m = 0; m < 4; ++m) _Pragma("unroll") for (int k = 0; k < 2; ++k) dst[m][k] = *(const PG8_LAS bf16x8*)(lds + PG8_SA(b, h) + aoff + m * 2048 + k * 1024); } while (0)
#define PG8_LDB(dst, b, h) do { _Pragma("unroll") for (int n = 0; n < 2; ++n) _Pragma("unroll") for (int k = 0; k < 2; ++k) dst[n][k] = *(const PG8_LAS bf16x8*)(lds + PG8_SB(b, h) + boff + n * 2048 + k * 1024); } while (0)
#define PG8_MMA(ai, bj, At, Bt) do { __builtin_amdgcn_s_setprio(1); _Pragma("unroll") for (int m = 0; m < 4; ++m) _Pragma("unroll") for (int n = 0; n < 2; ++n) _Pragma("unroll") for (int k = 0; k < 2; ++k) \
        acc[ai][bj][m][n] = __builtin_amdgcn_mfma_f32_16x16x32_f16(__builtin_bit_cast(pg8::f16x8, Bt[n][k]), __builtin_bit_cast(pg8::f16x8, At[m][k]), acc[ai][bj][m][n], 0, 0, 0); __builtin_amdgcn_s_setprio(0); } while (0)
#define PG8_WAIT_V(n) asm volatile("s_waitcnt vmcnt(" #n ")" ::: "memory")
#define PG8_WAIT_L(n) asm volatile("s_waitcnt lgkmcnt(" #n ")" ::: "memory")
#define PG8_BAR __builtin_amdgcn_s_barrier()
#define PG8_SCHED __builtin_amdgcn_sched_barrier(0)
    Unit cur, nxt; int ui = 0;
    if (!S.next(0, cur)) return;
    f32x4 acc[2][2][4][2];
#pragma unroll
    for (int a = 0; a < 2; ++a)
#pragma unroll
        for (int b = 0; b < 2; ++b)
#pragma unroll
            for (int m = 0; m < 4; ++m)
#pragma unroll
                for (int n = 0; n < 2; ++n) acc[a][b][m][n] = (f32x4){0.f, 0.f, 0.f, 0.f};
    bf16x8 At[4][2], B0[2][2], B1[2][2];
    const char* cA = (const char*)g.A + (size_t)cur.pm * tstep; const char* cB = (const char*)g.Bt + (size_t)cur.pn * tstep;
    S.a_ready(cur);
    if constexpr (SP2) {
        PG8_STAGE(PG8_SB(0, 0), cB, voffB); PG8_STAGE(PG8_SB(0, 1), cB + hstep, voffB); PG8_STAGE(PG8_SA(0, 0), cA, voffA); PG8_STAGE(PG8_SA(0, 1), cA + hstep, voffA);
        if (wr == 1) PG8_BAR;
        PG8_WAIT_V(2); PG8_BAR;
        PG8_STAGE(PG8_SB(1, 0), cB + kstep, voffB); PG8_STAGE(PG8_SA(1, 0), cA + kstep, voffA); PG8_STAGE(PG8_SB(1, 1), cB + hstep + kstep, voffB);
        PG8_WAIT_V(6); PG8_BAR;
    } else {
        PG8_STAGE(PG8_SB(0, 0), cB, voffB); PG8_STAGE(PG8_SA(0, 0), cA, voffA); PG8_STAGE(PG8_SB(0, 1), cB + hstep, voffB); PG8_STAGE(PG8_SA(0, 1), cA + hstep, voffA);
        if (wr == 1) PG8_BAR;
        PG8_WAIT_V(4); PG8_BAR;
        PG8_STAGE(PG8_SB(1, 0), cB + kstep, voffB); PG8_STAGE(PG8_SA(1, 0), cA + kstep, voffA); PG8_STAGE(PG8_SB(1, 1), cB + hstep + kstep, voffB);
        PG8_WAIT_V(6); PG8_BAR;
    }
    for (;;) {
        const bool has_next = S.next(ui + 1, nxt);
        const char* nA = has_next ? (const char*)g.A + (size_t)nxt.pm * tstep : cA; const char* nB = has_next ? (const char*)g.Bt + (size_t)nxt.pn * tstep : cB;
        for (int t = 0; t < nt; t += 2) {
            const bool last = (t == nt - 2);
            const char* a1 = cA + (size_t)(t + 1) * kstep;
            const char* a2 = last ? nA : cA + (size_t)(t + 2) * kstep; const char* b2 = last ? nB : cB + (size_t)(t + 2) * kstep;
            const char* a3 = a2 + kstep; const char* b3 = b2 + kstep;
            if (last && has_next) S.a_ready(nxt);
            if constexpr (SP2) {
            PG8_LDB(B0, 0, 0); PG8_LDB(B1, 0, 1); PG8_SCHED; PG8_LDA(At, 0, 0); PG8_STAGE(PG8_SA(1, 1), a1 + hstep, voffA);
            PG8_WAIT_V(8); PG8_WAIT_L(0); PG8_BAR; PG8_MMA(0, 0, At, B0); PG8_MMA(0, 1, At, B1); PG8_BAR; PG8_SCHED;
            PG8_LDA(At, 0, 1); PG8_STAGE(PG8_SB(0, 0), b2, voffB); PG8_STAGE(PG8_SB(0, 1), b2 + hstep, voffB); PG8_STAGE(PG8_SA(0, 0), a2, voffA);
            PG8_WAIT_V(8); PG8_WAIT_L(0); PG8_BAR; PG8_MMA(1, 0, At, B0); PG8_MMA(1, 1, At, B1); PG8_BAR; PG8_SCHED;
            PG8_LDB(B0, 1, 0); PG8_LDB(B1, 1, 1); PG8_SCHED; PG8_LDA(At, 1, 0); PG8_STAGE(PG8_SA(0, 1), a2 + hstep, voffA);
            PG8_WAIT_V(8); PG8_WAIT_L(0); PG8_BAR; PG8_MMA(0, 0, At, B0); PG8_MMA(0, 1, At, B1); PG8_BAR; PG8_SCHED;
            PG8_LDA(At, 1, 1); PG8_STAGE(PG8_SB(1, 0), b3, voffB); PG8_STAGE(PG8_SB(1, 1), b3 + hstep, voffB); PG8_STAGE(PG8_SA(1, 0), a3, voffA);
            PG8_WAIT_V(8); PG8_WAIT_L(0); PG8_BAR; PG8_MMA(1, 0, At, B0); PG8_MMA(1, 1, At, B1); PG8_BAR; PG8_SCHED;
            } else {
            PG8_LDB(B0, 0, 0); PG8_SCHED; PG8_LDA(At, 0, 0); PG8_STAGE(PG8_SA(1, 1), a1 + hstep, voffA);
            PG8_WAIT_L(8); PG8_BAR; PG8_WAIT_L(0); PG8_MMA(0, 0, At, B0); PG8_BAR; PG8_SCHED;
            PG8_LDB(B1, 0, 1); PG8_STAGE(PG8_SB(0, 0), b2, voffB);
            PG8_BAR; PG8_WAIT_L(0); PG8_MMA(0, 1, At, B1); PG8_BAR;
            PG8_LDA(At, 0, 1); PG8_STAGE(PG8_SA(0, 0), a2, voffA);
            PG8_BAR; PG8_WAIT_L(0); PG8_MMA(1, 0, At, B0); PG8_BAR; PG8_SCHED;
            PG8_STAGE(PG8_SB(0, 1), b2 + hstep, voffB);
            PG8_WAIT_V(6); PG8_BAR; PG8_MMA(1, 1, At, B1); PG8_BAR;
            PG8_LDB(B0, 1, 0); PG8_SCHED; PG8_LDA(At, 1, 0); PG8_STAGE(PG8_SA(0, 1), a2 + hstep, voffA);
            PG8_WAIT_L(8); PG8_BAR; PG8_WAIT_L(0); PG8_MMA(0, 0, At, B0); PG8_BAR; PG8_SCHED;
            PG8_LDB(B1, 1, 1); PG8_STAGE(PG8_SB(1, 0), b3, voffB);
            PG8_BAR; PG8_WAIT_L(0); PG8_MMA(0, 1, At, B1); PG8_BAR;
            PG8_LDA(At, 1, 1); PG8_STAGE(PG8_SA(1, 0), a3, voffA);
            PG8_BAR; PG8_WAIT_L(0); PG8_MMA(1, 0, At, B0); PG8_BAR; PG8_SCHED;
            PG8_STAGE(PG8_SB(1, 1), b3 + hstep, voffB);
            PG8_WAIT_V(6); PG8_BAR; PG8_MMA(1, 1, At, B1); PG8_BAR;
            }
        }
        if constexpr (ALIGN_EPI) { if (wr == 0) PG8_BAR; }
        if constexpr (!Epi::AFTER_DRAIN) { E(acc, cur, wr, wc, fr, fq); S.done(cur); }
        if (!has_next) break;
#pragma unroll
        for (int a = 0; a < 2; ++a)
#pragma unroll
            for (int b = 0; b < 2; ++b)
#pragma unroll
                for (int m = 0; m < 4; ++m)
#pragma unroll
                    for (int n = 0; n < 2; ++n) acc[a][b][m][n] = (f32x4){0.f, 0.f, 0.f, 0.f};
        cur = nxt; cA = nA; cB = nB; ++ui;
        if constexpr (ALIGN_EPI) { if (wr == 1) PG8_BAR; }
    }
    PG8_WAIT_V(0);
    if constexpr (!ALIGN_EPI) { if (wr == 0) PG8_BAR; }
    PG8_BAR;
    if constexpr (Epi::AFTER_DRAIN) { E.fused(acc, cur, wr, wc, fr, fq, lds, wid, lane); S.done(cur); }
#undef PG8_SA
#undef PG8_SB
#undef PG8_STAGE
#undef PG8_LDA
#undef PG8_LDB
#undef PG8_MMA
#undef PG8_WAIT_V
#undef PG8_WAIT_L
#undef PG8_BAR
#undef PG8_SCHED
}
}

typedef unsigned short bf16_t;
typedef short bf16x8 __attribute__((ext_vector_type(8)));
typedef short s16x4 __attribute__((ext_vector_type(4)));
typedef float f32x4 __attribute__((ext_vector_type(4)));
typedef float f32x16 __attribute__((ext_vector_type(16)));
typedef unsigned u32x4 __attribute__((ext_vector_type(4)));
typedef unsigned u32x2 __attribute__((ext_vector_type(2)));
#define LAS3 __attribute__((address_space(3)))

constexpr int DM = 1024, NB = 8, SEQ = 4096, LT = 4112, T = NB * LT, TP = 33024, NREAL = NB * SEQ;
constexpr int NQKV = 1280, DFF = 4096, NC = 5120;
constexpr int LK = 4160, KF = 2 * LK, MF = 4352;
constexpr float EPS = 1e-6f;
constexpr size_t MiB = 1u << 20;
constexpr size_t WS_ROWSS = 0;
constexpr size_t WS_LB = 704512;
constexpr size_t WS_BAR = 720896;
constexpr size_t WS_HMETA = 1 * MiB;
constexpr size_t W_UCS = 2 * MiB;
constexpr size_t W_QKV = W_UCS + 1 * MiB;
constexpr size_t W_O0 = W_QKV + 2560 * 1024;
constexpr size_t W_1_0 = W_O0 + 4 * MiB;
constexpr size_t W_2_0 = W_1_0 + 16 * MiB;
constexpr size_t W_C = W_2_0 + 16 * MiB;
constexpr size_t W_END = W_C + 10 * MiB;
constexpr size_t WS_HB = 52 * MiB;
constexpr size_t WS_Y = 117 * MiB;
constexpr size_t WS_BIG = 182 * MiB;
constexpr size_t WS_ZQ = WS_BIG, WS_UCST = WS_BIG + 81 * MiB, WS_ADFT = WS_BIG + 114 * MiB, WS_HID = WS_BIG, WS_Z1 = WS_BIG;
constexpr size_t WS_NEED = WS_BIG + (size_t)TP * NC * 2;
static_assert(W_END <= WS_HB && WS_HB + (size_t)TP * DM * 2 <= WS_Y && WS_Y + (size_t)TP * DM * 2 <= WS_BIG, "ws map");
static_assert(WS_ZQ + (size_t)TP * NQKV * 2 <= WS_UCST && WS_UCST + (size_t)2048 * KF * 2 <= WS_ADFT && WS_ADFT + (size_t)MF * KF * 2 <= WS_NEED, "ws map 2");
static_assert(WS_NEED <= 512 * MiB, "ws size");
constexpr int LDS_BYTES = 147456;

struct Params {
    const float* x; const float* meta; const float* mix_gain; const float* ab_w_in; const float* ab_q_gain; const float* ab_k_gain; const float* ab_w_out;
    const float* c_w_in; const float* c_lb; const float* c_o_gain; const float* c_w_out; const float* mlp_gain; const float* mlp_w1; const float* mlp_w2; const float* final_gain;
    float* out; unsigned char* ws;
};

typedef _Float16 f16x2 __attribute__((ext_vector_type(2)));
typedef _Float16 f16x8 __attribute__((ext_vector_type(8)));
typedef float f32x2 __attribute__((ext_vector_type(2)));
__device__ __forceinline__ unsigned pk2(float lo, float hi) { const f32x2 v = {lo, hi}; const f16x2 h = __builtin_convertvector(v, f16x2); return __builtin_bit_cast(unsigned, h); }
__device__ __forceinline__ bf16_t f2b(float v) { const _Float16 h = (_Float16)v; return __builtin_bit_cast(unsigned short, h); }
__device__ __forceinline__ float b2f(bf16_t v) { return (float)__builtin_bit_cast(_Float16, v); }
__device__ __forceinline__ float blo(unsigned w) { return b2f((bf16_t)(w & 0xffffu)); }
__device__ __forceinline__ float bhi(unsigned w) { return b2f((bf16_t)(w >> 16)); }
__device__ __forceinline__ unsigned pk2_bf(float lo, float hi) { unsigned r; asm volatile("v_cvt_pk_bf16_f32 %0, %1, %2" : "=v"(r) : "v"(lo), "v"(hi)); return r; }
__device__ __forceinline__ bf16_t f2bf(float v) { return (bf16_t)(pk2_bf(v, v) & 0xffffu); }
__device__ __forceinline__ f32x16 mfma32(bf16x8 a, bf16x8 b, f32x16 c) { return __builtin_amdgcn_mfma_f32_32x32x16_f16(__builtin_bit_cast(f16x8, a), __builtin_bit_cast(f16x8, b), c, 0, 0, 0); }
__device__ __forceinline__ const Params& KP() { const void* p = (const void*)__builtin_amdgcn_kernarg_segment_ptr(); asm volatile("" : "+s"(p)); return *(const Params*)p; }
__device__ __forceinline__ int otid() { int t = threadIdx.x; asm volatile("" : "+v"(t)); return t; }
__device__ __forceinline__ int crow(int r, int hi) { return (r & 3) + 8 * (r >> 2) + 4 * hi; }
__device__ __forceinline__ float wave_sum(float v) {
#pragma unroll
    for (int o = 32; o > 0; o >>= 1) v += __shfl_xor(v, o);
    return v;
}
__device__ __forceinline__ float rstd_of(float ss) { return rsqrtf(ss * (1.0f / 1024.0f) + EPS); }
template <int ACT> struct EpiAct {
    static constexpr bool PERM = true, AFTER_DRAIN = false;
    bf16_t* O; int ldc; const float* rowss;
    __device__ __forceinline__ void operator()(const f32x4 (&acc)[2][2][4][2], const pg8::Unit& u, int wr, int wc, int fr, int fq) const {
        const int row0 = u.pm * 256 + wr * 64 + fr, col0 = u.pn * 256 + wc * 32 + 8 * fq;
        float rsv[2][4];
#pragma unroll
        for (int ai = 0; ai < 2; ++ai)
#pragma unroll
            for (int m = 0; m < 4; ++m) rsv[ai][m] = rowss[row0 + ai * 128 + m * 16];
#pragma unroll
        for (int ai = 0; ai < 2; ++ai)
#pragma unroll
            for (int m = 0; m < 4; ++m) rsv[ai][m] = rstd_of(rsv[ai][m]);
#pragma unroll
        for (int ai = 0; ai < 2; ++ai)
#pragma unroll
            for (int m = 0; m < 4; ++m) {
                const int row = row0 + ai * 128 + m * 16; const float rs = rsv[ai][m];
                bf16_t* rowp = O + (size_t)row * ldc + col0;
#pragma unroll
                for (int bj = 0; bj < 2; ++bj) {
                    f32x4 v0 = acc[ai][bj][m][0] * rs, v1 = acc[ai][bj][m][1] * rs;
                    if (ACT == 1) {
#pragma unroll
                        for (int j = 0; j < 4; ++j) { float a = fmaxf(v0[j], 0.f), b = fmaxf(v1[j], 0.f); v0[j] = a * a; v1[j] = b * b; }
                    }
                    u32x4 w; w.x = pk2(v0[0], v0[1]); w.y = pk2(v0[2], v0[3]); w.z = pk2(v1[0], v1[1]); w.w = pk2(v1[2], v1[3]);
                    __builtin_nontemporal_store(w, (u32x4*)(rowp + bj * 128));
                }
            }
    }
};
struct EpiUcs {
    static constexpr bool PERM = true, AFTER_DRAIN = false;
    bf16_t* U; const float* rowss;
    __device__ __forceinline__ void operator()(const f32x4 (&acc)[2][2][4][2], const pg8::Unit& u, int wr, int wc, int fr, int fq) const {
        const int part = u.pm;
        f32x4 sv[2][2];
#pragma unroll
        for (int bj = 0; bj < 2; ++bj) { const int t0 = u.pn * 256 + bj * 128 + wc * 32 + 8 * fq; sv[bj][0] = *(const f32x4*)(rowss + t0); sv[bj][1] = *(const f32x4*)(rowss + t0 + 4); }
#pragma unroll
        for (int bj = 0; bj < 2; ++bj) {
            const int t0 = u.pn * 256 + bj * 128 + wc * 32 + 8 * fq;
            if (t0 < T) {
                int b, p; if (t0 < NREAL) { b = t0 >> 12; p = 16 + (t0 & 4095); } else { b = (t0 - NREAL) >> 4; p = (t0 - NREAL) & 15; }
                const f32x4 s0 = sv[bj][0], s1 = sv[bj][1];
                f32x4 r0, r1; r0[0] = rstd_of(s0[0]); r0[1] = rstd_of(s0[1]); r0[2] = rstd_of(s0[2]); r0[3] = rstd_of(s0[3]); r1[0] = rstd_of(s1[0]); r1[1] = rstd_of(s1[1]); r1[2] = rstd_of(s1[2]); r1[3] = rstd_of(s1[3]);
#pragma unroll
                for (int ai = 0; ai < 2; ++ai)
#pragma unroll
                    for (int m = 0; m < 4; ++m) {
                        const int c = ai * 128 + wr * 64 + m * 16 + fr;
                        const f32x4 v0 = acc[ai][bj][m][0] * r0, v1 = acc[ai][bj][m][1] * r1;
                        u32x4 w; w.x = pk2(v0[0], v0[1]); w.y = pk2(v0[2], v0[3]); w.z = pk2(v1[0], v1[1]); w.w = pk2(v1[2], v1[3]);
                        __builtin_nontemporal_store(w, (u32x4*)(U + (size_t)(b * 256 + c) * KF + part * LK + p));
                    }
            }
        }
    }
};
struct EpiFour {
    static constexpr bool PERM = true, AFTER_DRAIN = false;
    bf16_t* Y;
    __device__ __forceinline__ void operator()(const f32x4 (&acc)[2][2][4][2], const pg8::Unit& u, int wr, int wc, int fr, int fq) const {
        const int row0 = u.pm * 256 + wr * 64 + fr, col0 = wc * 32 + 8 * fq;
#pragma unroll
        for (int ai = 0; ai < 2; ++ai)
#pragma unroll
            for (int m = 0; m < 4; ++m) {
                const int lp = row0 + ai * 128 + m * 16;
                if (lp < LT) {
                    bf16_t* rowp = Y + (size_t)(lp < 16 ? NREAL + u.pn * 16 + lp : u.pn * SEQ + lp - 16) * DM + col0;
#pragma unroll
                    for (int bj = 0; bj < 2; ++bj) {
                        const f32x4 v0 = acc[ai][bj][m][0], v1 = acc[ai][bj][m][1];
                        u32x4 w; w.x = pk2(v0[0], v0[1]); w.y = pk2(v0[2], v0[3]); w.z = pk2(v1[0], v1[1]); w.w = pk2(v1[2], v1[3]);
                        __builtin_nontemporal_store(w, (u32x4*)(rowp + bj * 128));
                    }
                }
            }
    }
};
struct EpiHgrn {
    static constexpr bool PERM = true, AFTER_DRAIN = false;
    bf16_t* O; const float* rowss; const float* lb;
    template <int MODE>
    __device__ __forceinline__ void body(const f32x4 (&acc)[2][2][4][2], const float (&rsv)[2][4], const f32x4 (&lbv)[2][2], int row0, int col0) const {
#pragma unroll
        for (int ai = 0; ai < 2; ++ai)
#pragma unroll
            for (int m = 0; m < 4; ++m) {
                const int row = row0 + ai * 128 + m * 16; const float rs = rsv[ai][m];
                bf16_t* rowp = O + (size_t)row * NC + col0;
#pragma unroll
                for (int bj = 0; bj < 2; ++bj) {
                    f32x4 v[2]; v[0] = acc[ai][bj][m][0] * rs; v[1] = acc[ai][bj][m][1] * rs;
                    if (MODE != 2) {
#pragma unroll
                        for (int n = 0; n < 2; ++n)
#pragma unroll
                            for (int j = 0; j < 4; ++j) {
                                const float x = v[n][j];
                                if (MODE == 0) v[n][j] = x * __builtin_amdgcn_rcpf(1.0f + __expf(-x));
                                else v[n][j] = (1.0f - lbv[bj][n][j]) * __builtin_amdgcn_rcpf(1.0f + __expf(x));
                            }
                    }
                    u32x4 w; w.x = pk2(v[0][0], v[0][1]); w.y = pk2(v[0][2], v[0][3]); w.z = pk2(v[1][0], v[1][1]); w.w = pk2(v[1][2], v[1][3]);
                    __builtin_nontemporal_store(w, (u32x4*)(rowp + bj * 128));
                }
            }
    }
    __device__ __forceinline__ void operator()(const f32x4 (&acc)[2][2][4][2], const pg8::Unit& u, int wr, int wc, int fr, int fq) const {
        const int typ = u.pn >> 2;
        const int row0 = u.pm * 256 + wr * 64 + fr, col0 = u.pn * 256 + wc * 32 + 8 * fq;
        f32x4 lbv[2][2];
#pragma unroll
        for (int bj = 0; bj < 2; ++bj) {
            if (typ == 1 || typ == 2) { const float* lp = lb + (col0 - 1024 + bj * 128); lbv[bj][0] = *(const f32x4*)lp; lbv[bj][1] = *(const f32x4*)(lp + 4); }
            else { lbv[bj][0] = (f32x4){0.f, 0.f, 0.f, 0.f}; lbv[bj][1] = lbv[bj][0]; }
        }
        float rsv[2][4];
#pragma unroll
        for (int ai = 0; ai < 2; ++ai)
#pragma unroll
            for (int m = 0; m < 4; ++m) rsv[ai][m] = rowss[row0 + ai * 128 + m * 16];
#pragma unroll
        for (int ai = 0; ai < 2; ++ai)
#pragma unroll
            for (int m = 0; m < 4; ++m) rsv[ai][m] = rstd_of(rsv[ai][m]);
        if (typ == 3) body<2>(acc, rsv, lbv, row0, col0);
        else if (typ == 1 || typ == 2) body<1>(acc, rsv, lbv, row0, col0);
        else body<0>(acc, rsv, lbv, row0, col0);
    }
};
struct EpiRes {
    static constexpr bool PERM = true, AFTER_DRAIN = false;
    bf16_t* HB; float* rowss_next;
    __device__ __forceinline__ void operator()(const f32x4 (&acc)[2][2][4][2], const pg8::Unit& u, int wr, int wc, int fr, int fq) const {
        const int row0 = u.pm * 256 + wr * 64 + fr, col0 = u.pn * 256 + wc * 32 + 8 * fq;
#pragma unroll
        for (int ai = 0; ai < 2; ++ai)
#pragma unroll
            for (int m = 0; m < 4; ++m) {
                const int row = row0 + ai * 128 + m * 16;
                float ss = 0.f;
                {
                    bf16_t* bp = HB + (size_t)row * DM + col0;
                    const u32x4 o0 = *(const u32x4*)bp, o1 = *(const u32x4*)(bp + 128);
#pragma unroll
                    for (int bj = 0; bj < 2; ++bj) {
                        const u32x4 o = bj ? o1 : o0;
                        const f32x4 a0 = acc[ai][bj][m][0], a1 = acc[ai][bj][m][1];
                        u32x4 w;
                        w.x = pk2(blo(o.x) + a0[0], bhi(o.x) + a0[1]); w.y = pk2(blo(o.y) + a0[2], bhi(o.y) + a0[3]);
                        w.z = pk2(blo(o.z) + a1[0], bhi(o.z) + a1[1]); w.w = pk2(blo(o.w) + a1[2], bhi(o.w) + a1[3]);
                        __builtin_nontemporal_store(w, (u32x4*)(bp + bj * 128));
                        const float h0 = blo(w.x), h1 = bhi(w.x), h2 = blo(w.y), h3 = bhi(w.y), h4 = blo(w.z), h5 = bhi(w.z), h6 = blo(w.w), h7 = bhi(w.w);
                        ss += ((h0 * h0 + h1 * h1) + (h2 * h2 + h3 * h3)) + ((h4 * h4 + h5 * h5) + (h6 * h6 + h7 * h7));
                    }
                }
                ss += __shfl_xor(ss, 16); ss += __shfl_xor(ss, 32);
                if (fq == 0) atomicAdd(rowss_next + row, ss);
            }
    }
};

struct EpiDummy {
    static constexpr bool PERM = true, AFTER_DRAIN = false;
    float* sink;
    __device__ __forceinline__ void operator()(const f32x4 (&acc)[2][2][4][2], const pg8::Unit& u, int wr, int wc, int fr, int fq) const {
        if (sink) { f32x4 t = {0.f, 0.f, 0.f, 0.f};
#pragma unroll
            for (int a = 0; a < 2; ++a)
#pragma unroll
                for (int b = 0; b < 2; ++b)
#pragma unroll
                    for (int m = 0; m < 4; ++m) { t += acc[a][b][m][0]; t += acc[a][b][m][1]; }
            *(f32x4*)(sink + (size_t)(u.pm * 4 + u.pn) * 2048 + (wr * 4 + wc) * 256 + (fr * 4 + fq) * 4) = t; }
    }
};
template <class Epi>
__device__ __forceinline__ void meta_gemm(const bf16_t* __restrict__ A, int lda, const bf16_t* __restrict__ Bt, int K, int N, const Epi& E, unsigned char* lds) {
    const int tid = otid(), wid = tid >> 6, lane = tid & 63, l16 = lane & 15, q = lane >> 4;
    float* red = (float*)lds;
    const int ks = K >> 3;
    for (int g = blockIdx.x; g < (N >> 4); g += gridDim.x) {
        const bf16_t* bp = Bt + (size_t)(16 * g + l16) * K + wid * ks + 8 * q;
        const bf16_t* ap = A + (size_t)l16 * lda + wid * ks + 8 * q;
        f32x4 acc[8];
#pragma unroll
        for (int rb = 0; rb < 8; ++rb) acc[rb] = (f32x4){0.f, 0.f, 0.f, 0.f};
#pragma unroll 2
        for (int k = 0; k < ks; k += 32) {
            const f16x8 bf = __builtin_bit_cast(f16x8, *(const bf16x8*)(bp + k));
#pragma unroll
            for (int rb = 0; rb < 8; ++rb)
                acc[rb] = __builtin_amdgcn_mfma_f32_16x16x32_f16(__builtin_bit_cast(f16x8, *(const bf16x8*)(ap + (size_t)(16 * rb) * lda + k)), bf, acc[rb], 0, 0, 0);
        }
#pragma unroll
        for (int rb = 0; rb < 8; ++rb) *(f32x4*)(red + ((wid * 8 + rb) * 64 + lane) * 4) = acc[rb];
        __syncthreads();
        f32x4 sum = {0.f, 0.f, 0.f, 0.f};
#pragma unroll
        for (int w2 = 0; w2 < 8; ++w2) sum += *(const f32x4*)(red + ((w2 * 8 + wid) * 64 + lane) * 4);
        E(NREAL + 16 * wid + 4 * q, 16 * g + l16, sum);
        __syncthreads();
    }
}
struct MetaRes {
    bf16_t* HB; float* rowss_next;
    __device__ __forceinline__ void operator()(int row0, int col, const f32x4& acc) const {
#pragma unroll
        for (int i = 0; i < 4; ++i) {
            bf16_t* p = HB + (size_t)(row0 + i) * DM + col;
            const bf16_t hn = f2b(b2f(*p) + acc[i]); *p = hn;
            float ss = b2f(hn); ss *= ss;
            ss += __shfl_xor(ss, 1); ss += __shfl_xor(ss, 2); ss += __shfl_xor(ss, 4); ss += __shfl_xor(ss, 8);
            if ((threadIdx.x & 15) == 0) atomicAdd(rowss_next + row0 + i, ss);
        }
    }
};
struct MetaUp {
    bf16_t* O; const float* rowss;
    __device__ __forceinline__ void operator()(int row0, int col, const f32x4& acc) const {
#pragma unroll
        for (int i = 0; i < 4; ++i) { const float v = fmaxf(acc[i] * rstd_of(rowss[row0 + i]), 0.f); O[(size_t)(row0 + i) * DFF + col] = f2b(v * v); }
    }
};
struct MetaHgrn {
    bf16_t* O; const float* rowss; const float* lb;
    __device__ __forceinline__ void operator()(int row0, int col, const f32x4& acc) const {
        const int typ = col >> 10;
        const float l = (typ == 1 || typ == 2) ? lb[col - 1024] : 0.f;
#pragma unroll
        for (int i = 0; i < 4; ++i) {
            const float x = acc[i] * rstd_of(rowss[row0 + i]); float r;
            if (typ == 0 || typ == 4) r = x * __builtin_amdgcn_rcpf(1.0f + __expf(-x));
            else if (typ == 3) r = x;
            else r = (1.0f - l) * __builtin_amdgcn_rcpf(1.0f + __expf(x));
            O[(size_t)(row0 + i) * NC + col] = f2b(r);
        }
    }
};

__device__ __forceinline__ void gen_adft(const Params& P, int bx, int G) {
    const int tid = otid(); unsigned char* ws = P.ws;
    const long gtid = (long)bx * 512 + tid, gthreads = (long)G * 512;
    {
        bf16_t* A = (bf16_t*)(ws + WS_ADFT);
        const long nch = (long)MF * (KF / 8);
        for (long ci = gtid; ci < nch; ci += gthreads) {
            const int lp = (int)(ci / (KF / 8)); const int cj = (int)(ci - (long)lp * (KF / 8));
            const int j0 = cj * 8; const int part = j0 >= LK ? 1 : 0; const int l0 = j0 - part * LK;
            u32x4 w = {0u, 0u, 0u, 0u};
            if (lp < LT && l0 < LT) {
                int mm = (int)(((long)lp * l0) % LT);
                float v[8];
#pragma unroll
                for (int e = 0; e < 8; ++e) {
                    const float rev = (float)mm * (1.0f / (float)LT);
                    v[e] = part ? -__builtin_amdgcn_sinf(rev) : __builtin_amdgcn_cosf(rev);
                    mm += lp; if (mm >= LT) mm -= LT;
                }
                w.x = pk2(v[0], v[1]); w.y = pk2(v[2], v[3]); w.z = pk2(v[4], v[5]); w.w = pk2(v[6], v[7]);
            }
            __builtin_nontemporal_store(w, (u32x4*)(A + (size_t)lp * KF + j0));
        }
    }
}

__device__ __forceinline__ void weight_jobs(const Params& P, unsigned char* lds, int job_lo, int job_hi, int bx, int G) {
    const int tid = otid();
    unsigned char* ws = P.ws;
    float* tile = (float*)lds;
#pragma nounroll
    for (int job = job_lo; job < job_hi; ++job) {
        const float* src; int ld, coff, K, N; bf16_t* dst; const float* gain;
        switch (job) {
            case 0: src = P.ab_w_in; ld = 1536; coff = 256; K = 1024; N = 1280; dst = (bf16_t*)(ws + W_QKV); gain = P.mix_gain; break;
            case 1: src = P.ab_w_out; ld = 1024; coff = 0; K = 1024; N = 1024; dst = (bf16_t*)(ws + W_O0); gain = nullptr; break;
            case 2: src = P.mlp_w1; ld = 4096; coff = 0; K = 1024; N = 4096; dst = (bf16_t*)(ws + W_1_0); gain = P.mlp_gain; break;
            case 3: src = P.mlp_w1 + (size_t)1024 * 4096; ld = 4096; coff = 0; K = 1024; N = 4096; dst = (bf16_t*)(ws + W_1_0 + 8 * MiB); gain = P.mlp_gain + 1024; break;
            case 4: src = P.mlp_w2; ld = 1024; coff = 0; K = 4096; N = 1024; dst = (bf16_t*)(ws + W_2_0); gain = nullptr; break;
            case 5: src = P.mlp_w2 + (size_t)4096 * 1024; ld = 1024; coff = 0; K = 4096; N = 1024; dst = (bf16_t*)(ws + W_2_0 + 8 * MiB); gain = nullptr; break;
            case 6: src = P.c_w_in; ld = 5120; coff = 0; K = 1024; N = 5120; dst = (bf16_t*)(ws + W_C); gain = P.mix_gain + 1024; break;
            default: src = P.c_w_out; ld = 1024; coff = 0; K = 1024; N = 1024; dst = (bf16_t*)(ws + W_O0 + 2 * MiB); gain = nullptr; break;
        }
        const int nkt = K >> 6, nnt = N >> 6, ntile = nkt * nnt;
        const int kr = tid >> 3, c8 = (tid & 7) * 8;
        f32x4 ra, rb; float rgn = 1.f;
        if (bx < ntile) { const int kt = bx % nkt, nt = bx / nkt; const float* sp = src + (size_t)(kt * 64 + kr) * ld + coff + nt * 64 + c8; ra = *(const f32x4*)sp; rb = *(const f32x4*)(sp + 4); rgn = gain ? gain[kt * 64 + kr] : 1.0f; }
        for (int ti = bx; ti < ntile; ti += G) {
            const int kt = ti % nkt, nt = ti / nkt, k0 = kt * 64, n0 = nt * 64;
            { float* tp = tile + kr * 65 + c8;
              tp[0] = ra[0] * rgn; tp[1] = ra[1] * rgn; tp[2] = ra[2] * rgn; tp[3] = ra[3] * rgn; tp[4] = rb[0] * rgn; tp[5] = rb[1] * rgn; tp[6] = rb[2] * rgn; tp[7] = rb[3] * rgn; }
            __syncthreads();
            if (ti + G < ntile) {
                const int t2 = ti + G, kt2 = t2 % nkt, nt2 = t2 / nkt; const float* sp = src + (size_t)(kt2 * 64 + kr) * ld + coff + nt2 * 64 + c8;
                ra = *(const f32x4*)sp; rb = *(const f32x4*)(sp + 4); rgn = gain ? gain[kt2 * 64 + kr] : 1.0f; }
            { const int nr = tid >> 3, k8 = (tid & 7) * 8;
              const float* tp = tile + k8 * 65 + nr;
              u32x4 w; w.x = pk2(tp[0], tp[65]); w.y = pk2(tp[130], tp[195]); w.z = pk2(tp[260], tp[325]); w.w = pk2(tp[390], tp[455]);
              __builtin_nontemporal_store(w, (u32x4*)(dst + (size_t)(n0 + nr) * K + k0 + k8)); }
            __syncthreads();
        }
    }
}

__device__ __forceinline__ void p0_prologue(const Params& P, unsigned char* lds) {
    const int tid = otid(), lane = tid & 63, wid = tid >> 6;
    const int G = gridDim.x, bx = blockIdx.x;
    unsigned char* ws = P.ws;
    float* tile = (float*)lds;
    float* twc = (float*)(lds + 64 * 65 * 4);
    float* tws = twc + 64;
    if (tid < 64) { twc[tid] = __builtin_amdgcn_cosf((float)tid * (1.0f / 64.0f)); tws[tid] = __builtin_amdgcn_sinf((float)tid * (1.0f / 64.0f)); }
    __syncthreads();
    weight_jobs(P, lds, 0, 1, bx, G);
    {
        const float scale = 0.0019493177f;
        bf16_t* dst = (bf16_t*)(ws + W_UCS);
        for (int ti = bx; ti < 256; ti += G) {
            const int kt = ti & 63, g = ti >> 6, k0 = kt * 16;
            if (tid < 256) { const int kr = tid >> 4, c4 = (tid & 15) * 4;
              const f32x4 a = *(const f32x4*)(P.ab_w_in + (size_t)(k0 + kr) * 1536 + g * 64 + c4);
              const float gn = P.mix_gain[k0 + kr] * scale;
              float* tp = tile + kr * 65 + c4; tp[0] = a[0] * gn; tp[1] = a[1] * gn; tp[2] = a[2] * gn; tp[3] = a[3] * gn; }
            __syncthreads();
            { const int cp = tid >> 3, k2 = (tid & 7) * 2;
              float ac0 = 0.f, ac1 = 0.f, as0 = 0.f, as1 = 0.f;
              for (int c = 0; c < 64; ++c) {
                  const int mm = (c * cp) & 63; const float cw = twc[mm], sw = tws[mm];
                  const float v0 = tile[k2 * 65 + c], v1 = tile[(k2 + 1) * 65 + c];
                  ac0 += v0 * cw; ac1 += v1 * cw; as0 += v0 * sw; as1 += v1 * sw;
              }
              *(unsigned*)(dst + (size_t)(g * 64 + cp) * DM + k0 + k2) = pk2(ac0, ac1);
              *(unsigned*)(dst + (size_t)(256 + g * 64 + cp) * DM + k0 + k2) = pk2(as0, as1); }
            __syncthreads();
        }
    }
    {
        float* rowss = (float*)(ws + WS_ROWSS); bf16_t* HB = (bf16_t*)(ws + WS_HB); bf16_t* Y = (bf16_t*)(ws + WS_Y);
        const int nw = G * 8;
        for (int row0 = bx * 8 + wid; row0 < TP; row0 += 4 * nw) {
            f32x4 v[4][4];
#pragma unroll
            for (int r = 0; r < 4; ++r) { const int row = row0 + r * nw;
                if (row < T) { const float* src = (row < NREAL ? P.x + (size_t)row * DM : P.meta + (size_t)((row - NREAL) & 15) * DM) + lane * 16;
#pragma unroll
                    for (int i = 0; i < 4; ++i) v[r][i] = *(const f32x4*)(src + 4 * i); }
                else {
#pragma unroll
                    for (int i = 0; i < 4; ++i) v[r][i] = (f32x4){0.f, 0.f, 0.f, 0.f}; } }
#pragma unroll
            for (int r = 0; r < 4; ++r) { const int row = row0 + r * nw;
                if (row < TP) {
                    float ss = 0.f;
#pragma unroll
                    for (int i = 0; i < 4; ++i) ss += (v[r][i][0] * v[r][i][0] + v[r][i][1] * v[r][i][1]) + (v[r][i][2] * v[r][i][2] + v[r][i][3] * v[r][i][3]);
                    u32x4 w0, w1;
                    w0.x = pk2(v[r][0][0], v[r][0][1]); w0.y = pk2(v[r][0][2], v[r][0][3]); w0.z = pk2(v[r][1][0], v[r][1][1]); w0.w = pk2(v[r][1][2], v[r][1][3]);
                    w1.x = pk2(v[r][2][0], v[r][2][1]); w1.y = pk2(v[r][2][2], v[r][2][3]); w1.z = pk2(v[r][3][0], v[r][3][1]); w1.w = pk2(v[r][3][2], v[r][3][3]);
                    *(u32x4*)(HB + (size_t)row * DM + lane * 16) = w0; *(u32x4*)(HB + (size_t)row * DM + lane * 16 + 8) = w1;
                    if (row >= T) { const u32x4 z = {0u, 0u, 0u, 0u}; *(u32x4*)(Y + (size_t)row * DM + lane * 16) = z; *(u32x4*)(Y + (size_t)row * DM + lane * 16 + 8) = z; }
                    ss = wave_sum(ss);
                    if (lane == 0) rowss[row] = ss;
                    if (lane >= 1 && lane < 5) rowss[(size_t)lane * TP + row] = 0.f;
                }
            }
        }
    }
    const long gtid = (long)bx * 512 + tid, gthreads = (long)G * 512;
    if (gtid < 2048) {
        const int dir = (int)gtid >> 10, c = (int)gtid & 1023;
        const float l0 = P.c_lb[dir * 1024 + c], l1 = P.c_lb[2048 + dir * 1024 + c];
        ((float*)(ws + WS_LB))[gtid] = 1.0f / (1.0f + __expf(l0 - l1));
    }
    {
        bf16_t* U = (bf16_t*)(ws + WS_UCST);
        for (long i = gtid; i < 2048 * 12; i += gthreads) {
            const int row = (int)(i / 12), k = (int)(i % 12), seg = k / 6, e = k % 6;
            const u32x4 z = {0u, 0u, 0u, 0u};
            *(u32x4*)(U + (size_t)row * KF + seg * LK + LT + e * 8) = z;
        }
    }
}

__device__ __forceinline__ void qk_norm_rope(const Params& P, int dry = 0) {
    const int tid = otid(), lane = tid & 63, wid = tid >> 6;
    bf16_t* ZQ = (bf16_t*)(P.ws + WS_ZQ);
    const int head = lane >> 3, d0 = (lane & 7) * 8;
    const float* gain = head < 6 ? P.ab_q_gain : P.ab_k_gain;
    float inv[8], g1[8], g2[8];
#pragma unroll
    for (int e = 0; e < 8; ++e) { inv[e] = __builtin_amdgcn_exp2f(-(float)((d0 + e) & 31) * (13.287712379549449f / 32.0f)); g1[e] = gain[d0 + e]; g2[e] = gain[64 + d0 + e]; }
    const int nw = gridDim.x * 8, w0 = blockIdx.x * 8 + wid;
    for (int row = w0; row < T; row += 2 * nw) {
        const int rowb = row + nw; const bool hasb = rowb < T;
        bf16_t* za = ZQ + (size_t)row * NQKV + head * 128 + d0; bf16_t* zb = ZQ + (size_t)(hasb ? rowb : row) * NQKV + head * 128 + d0;
        const u32x4 a1 = *(const u32x4*)za, a2 = *(const u32x4*)(za + 64), b1 = *(const u32x4*)zb, b2 = *(const u32x4*)(zb + 64);
#pragma unroll
        for (int it = 0; it < 2; ++it) {
            const u32x4 w1 = it ? b1 : a1, w2 = it ? b2 : a2; const int r = it ? rowb : row; bf16_t* zp = it ? zb : za;
            float x1[8], x2[8];
            x1[0] = blo(w1.x); x1[1] = bhi(w1.x); x1[2] = blo(w1.y); x1[3] = bhi(w1.y); x1[4] = blo(w1.z); x1[5] = bhi(w1.z); x1[6] = blo(w1.w); x1[7] = bhi(w1.w);
            x2[0] = blo(w2.x); x2[1] = bhi(w2.x); x2[2] = blo(w2.y); x2[3] = bhi(w2.y); x2[4] = blo(w2.z); x2[5] = bhi(w2.z); x2[6] = blo(w2.w); x2[7] = bhi(w2.w);
            float ss = 0.f;
#pragma unroll
            for (int e = 0; e < 8; ++e) ss += x1[e] * x1[e] + x2[e] * x2[e];
            ss += __shfl_xor(ss, 1); ss += __shfl_xor(ss, 2); ss += __shfl_xor(ss, 4);
            const float rs = rsqrtf(ss * (1.0f / 128.0f) + EPS);
            float o1[8], o2[8];
            const bool real = r < NREAL; const int pos = r & 4095; const float pv = (float)((lane & 7) < 4 ? (pos >> 6) : (pos & 63));
#pragma unroll
            for (int e = 0; e < 8; ++e) {
                const float y1 = x1[e] * rs * g1[e], y2 = x2[e] * rs * g2[e];
                float c = 1.f, sn = 0.f;
                if (real) { float rev = pv * inv[e] * 0.15915494309189535f; rev -= floorf(rev); c = __builtin_amdgcn_cosf(rev); sn = __builtin_amdgcn_sinf(rev); }
                o1[e] = y1 * c - y2 * sn; o2[e] = y2 * c + y1 * sn;
            }
            if (!dry && (it == 0 || hasb)) {
                u32x4 v1, v2;
                v1.x = pk2(o1[0], o1[1]); v1.y = pk2(o1[2], o1[3]); v1.z = pk2(o1[4], o1[5]); v1.w = pk2(o1[6], o1[7]);
                v2.x = pk2(o2[0], o2[1]); v2.y = pk2(o2[2], o2[3]); v2.z = pk2(o2[4], o2[5]); v2.w = pk2(o2[6], o2[7]);
                *(u32x4*)zp = v1; *(u32x4*)(zp + 64) = v2;
            }
        }
    }
}

namespace att {
constexpr int QBLK = 32, KVBLK = 64, NW = 8;
constexpr float SCALE = 0.088388347648318440f;
constexpr float THR = 8.f;
constexpr size_t SHM_V = KVBLK * 128 * 2, SHM_K = KVBLK * 128 * 2, SHM_ATTN = 2 * SHM_V + 2 * SHM_K + NW * 64 * 4;
constexpr int NT = 66;
#define KSWZ(row, colB) ((row) * 256 + ((colB) ^ (((row) & 7) << 4)))
#define SBAR() __builtin_amdgcn_sched_barrier(0)
__device__ __forceinline__ void partialSM(f32x16& p0, f32x16& p1, float& m_reg, float& mn, float& alpha) {
  constexpr float C = SCALE * 1.4426950408889634f;
  float pmax = p0[0]; for (int r = 1; r < 16; ++r) pmax = fmaxf(pmax, p0[r]); for (int r = 0; r < 16; ++r) pmax = fmaxf(pmax, p1[r]);
  { auto rr = __builtin_amdgcn_permlane32_swap(__float_as_uint(pmax), __float_as_uint(pmax), false, false);
    pmax = fmaxf(__uint_as_float(rr[0]), __uint_as_float(rr[1])); }
  if (__builtin_expect(__all(pmax - m_reg <= THR / SCALE), 1)) { mn = m_reg; alpha = 1.f; }
  else { mn = fmaxf(m_reg, pmax); alpha = __builtin_amdgcn_exp2f((m_reg - mn) * C); m_reg = mn; }
  float mnC = -mn * C;
  for (int r = 0; r < 16; ++r) p0[r] = fmaf(p0[r], C, mnC); for (int r = 0; r < 16; ++r) p1[r] = fmaf(p1[r], C, mnC);
  for (int r = 0; r < 16; ++r) p0[r] = __builtin_amdgcn_exp2f(p0[r]);
}
__device__ __forceinline__ void finishSM(f32x16& p0, f32x16& p1, float alpha, float& l_reg, bf16x8& pa0, bf16x8& pa1, bf16x8& pa2, bf16x8& pa3) {
  for (int r = 0; r < 16; ++r) p1[r] = __builtin_amdgcn_exp2f(p1[r]);
  float ps = 0; for (int r = 0; r < 16; ++r) ps += p0[r]; for (int r = 0; r < 16; ++r) ps += p1[r];
  { auto rr = __builtin_amdgcn_permlane32_swap(__float_as_uint(ps), __float_as_uint(ps), false, false);
    ps = __uint_as_float(rr[0]) + __uint_as_float(rr[1]); }
  l_reg = l_reg * alpha + ps;
#define PK4(P, BASE, OUT) do { unsigned a0 = pk2(P[BASE + 0], P[BASE + 1]), a1 = pk2(P[BASE + 2], P[BASE + 3]);   \
    unsigned b0 = pk2(P[BASE + 4], P[BASE + 5]), b1 = pk2(P[BASE + 6], P[BASE + 7]);                              \
    auto r0 = __builtin_amdgcn_permlane32_swap(a0, b0, false, false); auto r1 = __builtin_amdgcn_permlane32_swap(a1, b1, false, false); \
    u32x4 w = {r0[0], r1[0], r0[1], r1[1]}; OUT = *reinterpret_cast<bf16x8*>(&w); } while (0)
  PK4(p0, 0, pa0); PK4(p0, 8, pa1); PK4(p1, 0, pa2); PK4(p1, 8, pa3);
#undef PK4
}
__device__ __forceinline__ void qkt(f32x16& p0, f32x16& p1, const bf16_t* Ks, const bf16x8* qr, int r32, int hi) {
  p0 = f32x16{}; p1 = f32x16{};
  for (int d0 = 0; d0 < 8; ++d0) { int cb = (d0 * 16 + hi * 8) * 2;
    bf16x8 b0 = *reinterpret_cast<const bf16x8*>((const char*)Ks + KSWZ(r32, cb));
    bf16x8 b1 = *reinterpret_cast<const bf16x8*>((const char*)Ks + KSWZ(32 + r32, cb));
    p0 = mfma32(b0, qr[d0], p0);
    p1 = mfma32(b1, qr[d0], p1); }
}
__device__ __forceinline__ void kmask(f32x16& p0, f32x16& p1, int tile, int hi) {
  if (tile >= 64) {
    const int lim = tile == 64 ? 16 : 0;
#pragma unroll
    for (int r = 0; r < 16; ++r) { if (crow(r, hi) >= lim) p0[r] = -1e30f; p1[r] = -1e30f; }
  }
}
__device__ __forceinline__ int v_st(int k, int c) { const int kk = (k & ~0xC) | ((k & 4) << 1) | ((k & 8) >> 1); return ((kk >> 3) * 4 + (c >> 5)) * 512 + ((kk & 7) * 32 + (c & 31)) * 2; }
__device__ __forceinline__ int v_rd_base(int lane) { return ((lane & 3) << 3) | (((lane >> 2) & 3) << 6) | (((lane >> 4) & 1) << 5) | (((lane >> 5) & 1) << 8); }
constexpr int v_rd_off(int d0, int ks, int half) { return d0 * 512 + ks * 4096 + half * 2048; }
template <int OFF> __device__ __forceinline__ s16x4 tr_read(int vb) {
  s16x4 r; asm volatile("ds_read_b64_tr_b16 %0, %1 offset:%2" : "=&v"(r) : "v"(vb), "i"(OFF) : "memory"); return r;
}
template <int D0> __device__ __forceinline__ void pv_one(f32x16& od, int vb, bf16x8 pa0, bf16x8 pa1, bf16x8 pa2, bf16x8 pa3) {
  const s16x4 l0 = tr_read<v_rd_off(D0, 0, 0)>(vb), h0 = tr_read<v_rd_off(D0, 0, 1)>(vb), l1 = tr_read<v_rd_off(D0, 1, 0)>(vb), h1 = tr_read<v_rd_off(D0, 1, 1)>(vb);
  const s16x4 l2 = tr_read<v_rd_off(D0, 2, 0)>(vb), h2 = tr_read<v_rd_off(D0, 2, 1)>(vb), l3 = tr_read<v_rd_off(D0, 3, 0)>(vb), h3 = tr_read<v_rd_off(D0, 3, 1)>(vb);
  asm volatile("s_waitcnt lgkmcnt(0)" ::: "memory"); SBAR();
#define PK(L, H) (bf16x8){L[0], L[1], L[2], L[3], H[0], H[1], H[2], H[3]}
  od = mfma32(pa0, PK(l0, h0), od);
  od = mfma32(pa1, PK(l1, h1), od);
  od = mfma32(pa2, PK(l2, h2), od);
  od = mfma32(pa3, PK(l3, h3), od);
#undef PK
}
__device__ __forceinline__ void pv_d0(f32x16* o, int vb, bf16x8 pa0, bf16x8 pa1, bf16x8 pa2, bf16x8 pa3) {
  pv_one<0>(o[0], vb, pa0, pa1, pa2, pa3); pv_one<1>(o[1], vb, pa0, pa1, pa2, pa3); pv_one<2>(o[2], vb, pa0, pa1, pa2, pa3); pv_one<3>(o[3], vb, pa0, pa1, pa2, pa3);
}
__device__ __forceinline__ void attn_unit(const bf16_t* __restrict__ ZQ, bf16_t* __restrict__ Y, int b, int hsel, int qb, char* lds) {
  const int tid = otid(), wid = tid >> 6, lane = tid & 63, r32 = lane & 31, hi = lane >> 5;
  bf16_t* V_lds = (bf16_t*)lds; bf16_t* K_lds = (bf16_t*)(lds + 2 * SHM_V);
  float* ws = (float*)(lds + 2 * SHM_V + 2 * SHM_K) + wid * 64; float* li_l = ws; float* al_l = ws + 32;
  float m_reg = -1e30f, l_reg = 0; f32x16 o[4] = {}; bf16x8 qr[8];
  const bool meta = qb >= 16;
  const int h = meta ? hsel * 3 + (wid < 3 ? wid : 2) : hsel; const int kvh = meta ? hsel : hsel / 3;
  const long tb_real = (long)b * SEQ, tb_meta = (long)NREAL + 16 * b;
  { const long qrow = meta ? tb_meta + (r32 & 15) : tb_real + qb * 256 + wid * QBLK + r32;
    const bf16_t* Qw = ZQ + qrow * NQKV + h * 128 + hi * 8;
#pragma unroll
    for (int d0 = 0; d0 < 8; ++d0) qr[d0] = *reinterpret_cast<const bf16x8*>(Qw + d0 * 16); }
  const bf16_t* Kh = ZQ + 768 + kvh * 128; const bf16_t* Vh = ZQ + 1024 + kvh * 128;
  constexpr int LDK = NQKV;
  const int sr = tid >> 4, sc = (tid & 15) * 8, vst0 = v_st(sr, sc), vst1 = v_st(32 + sr, sc);
  const int vb0 = (int)(uintptr_t)V_lds + v_rd_base(lane);
  struct { bf16x8 vs0, vs1, ks0, ks1; } sr_[1];
#define SLOAD(i, t) do { const long k0_ = ((t) < 64 ? tb_real + 64 * (t) : tb_meta); sr_[i].vs0 = *reinterpret_cast<const bf16x8*>(&Vh[(k0_ + sr) * LDK + sc]); sr_[i].vs1 = *reinterpret_cast<const bf16x8*>(&Vh[(k0_ + 32 + sr) * LDK + sc]); \
    sr_[i].ks0 = *reinterpret_cast<const bf16x8*>(&Kh[(k0_ + sr) * LDK + sc]); sr_[i].ks1 = *reinterpret_cast<const bf16x8*>(&Kh[(k0_ + 32 + sr) * LDK + sc]); } while (0)
#define SWRITE(bb, i) do { *(bf16x8*)((char*)V_lds + (bb) * SHM_V + vst0) = sr_[i].vs0;          \
    *(bf16x8*)((char*)V_lds + (bb) * SHM_V + vst1) = sr_[i].vs1; int kc = sc * 2;               \
    *(bf16x8*)((char*)K_lds + (bb) * SHM_K + KSWZ(sr, kc)) = sr_[i].ks0;                       \
    *(bf16x8*)((char*)K_lds + (bb) * SHM_K + KSWZ(32 + sr, kc)) = sr_[i].ks1; } while (0)
#define SWAIT() asm volatile("s_waitcnt vmcnt(0)" ::: "memory")
#define RESC(a) do { if (__any((a) < 1.f)) { if (hi == 0) al_l[r32] = (a); asm volatile("s_waitcnt lgkmcnt(0)" ::: "memory"); \
    for (int d = 0; d < 4; ++d) for (int r = 0; r < 16; ++r) o[d][r] *= al_l[crow(r, hi)]; } } while (0)
  f32x16 pA0, pA1, pB0, pB1; float mnA, mnB, alA, alB; bf16x8 pa0, pa1, pa2, pa3;
  constexpr int SE = 0, SO = 0;
  SLOAD(SE, 0); asm volatile("s_waitcnt vmcnt(0)" ::: "memory"); SWRITE(0, SE); __syncthreads();
  qkt(pA0, pA1, K_lds, qr, r32, hi); partialSM(pA0, pA1, m_reg, mnA, alA);
  SLOAD(SO, 1);
  SWAIT(); SWRITE(1, SO); __syncthreads();
  for (int j = 1; j + 1 < NT; j += 2) {
    SBAR(); qkt(pB0, pB1, (bf16_t*)((char*)K_lds + SHM_K), qr, r32, hi); kmask(pB0, pB1, j, hi);
    finishSM(pA0, pA1, alA, l_reg, pa0, pa1, pa2, pa3); SBAR();
    SLOAD(SO, j + 1); SBAR();
    pv_d0(o, vb0, pa0, pa1, pa2, pa3); partialSM(pB0, pB1, m_reg, mnB, alB);
    __syncthreads(); SWAIT(); SWRITE(0, SE);
    RESC(alB); __syncthreads();
    SBAR(); qkt(pA0, pA1, K_lds, qr, r32, hi); kmask(pA0, pA1, j + 1, hi);
    finishSM(pB0, pB1, alB, l_reg, pa0, pa1, pa2, pa3); SBAR();
    SLOAD(SE, j + 2); SBAR();
    pv_d0(o, vb0 + (int)SHM_V, pa0, pa1, pa2, pa3); partialSM(pA0, pA1, m_reg, mnA, alA);
    __syncthreads(); SWAIT(); SWRITE(1, SO);
    RESC(alA); __syncthreads();
  }
  SBAR(); finishSM(pA0, pA1, alA, l_reg, pa0, pa1, pa2, pa3); SBAR();
  pv_d0(o, vb0, pa0, pa1, pa2, pa3);
  if (hi == 0) li_l[r32] = l_reg; asm volatile("s_waitcnt lgkmcnt(0)" ::: "memory");
  float rli[16];
#pragma unroll
  for (int r = 0; r < 16; ++r) rli[r] = __builtin_amdgcn_rcpf(li_l[crow(r, hi)]);
#pragma unroll
  for (int r = 0; r < 16; ++r) { const int ri = crow(r, hi);
    if (!meta || (wid < 3 && ri < 16)) { bf16_t* yp = Y + (meta ? tb_meta + ri : tb_real + qb * 256 + wid * QBLK + ri) * DM + 256 + h * 128 + r32;
#pragma unroll
      for (int d0 = 0; d0 < 4; ++d0) yp[d0 * 32] = f2b(o[d0][r] * rli[r]); } }
  __syncthreads();
#undef SLOAD
#undef SWRITE
#undef SWAIT
#undef RESC
}
}

#define LBAR() asm volatile("s_waitcnt lgkmcnt(0)\n\ts_barrier" ::: "memory")
__device__ __forceinline__ void scan_unit(const bf16_t* __restrict__ Z1, bf16_t* __restrict__ OUT, int b, int h, int dir, int vs, unsigned char* lds, int dry = 0) {
    const int tid = otid(), wid = tid >> 6, lane = tid & 63, r32 = lane & 31, hi = lane >> 5;
    float* TOT = (float*)(lds); float* DVv = (float*)(lds + 4096);
    bf16_t* QT = (bf16_t*)(lds + 4608); bf16_t* KT = (bf16_t*)(lds + 22016); bf16_t* QI = (bf16_t*)(lds + 39424); bf16_t* KHT = (bf16_t*)(lds + 56832);
    bf16_t* VT = (bf16_t*)(lds + 75264); bf16_t* AS = (bf16_t*)(lds + 84480); bf16_t* SB = (bf16_t*)(lds + 93696);
    const int cp = tid & 63, seg = __builtin_amdgcn_readfirstlane(tid >> 6);
    const int vp = tid & 31, tgv = tid >> 5;
    const bf16_t* Qg = Z1 + h * 128 + 2 * cp; const bf16_t* Gg = Z1 + 1024 + dir * 1024 + h * 128 + 2 * cp; const bf16_t* Vg = Z1 + 3072 + h * 128 + vs * 64 + 2 * vp;
    f32x16 Sacc = {}; f32x16 oacc = {};
    for (int i = tid; i < 17408 / 4; i += 512) ((unsigned*)SB)[i] = 0u;
    int cur = 0;
    unsigned rq[8], rk[8], rv[4];
#define LOADC(cc) do { const int c_ = (cc); const long tk_ = c_ ? (long)b * SEQ + 64 * (c_ - 1) : (long)NREAL + 16 * b; \
    if (c_ != 0 || seg < 2) { const bf16_t* qp_ = Qg + (size_t)(tk_ + 8 * seg) * NC; const bf16_t* gp_ = Gg + (size_t)(tk_ + 8 * seg) * NC; \
        _Pragma("unroll") for (int i_ = 0; i_ < 8; ++i_) { rq[i_] = *(const unsigned*)qp_; rk[i_] = *(const unsigned*)gp_; qp_ += NC; gp_ += NC; } } \
    else { _Pragma("unroll") for (int i_ = 0; i_ < 8; ++i_) { rq[i_] = 0u; rk[i_] = 0u; } } \
    if (c_ != 0 || tgv < 4) { const bf16_t* vp_ = Vg + (size_t)(tk_ + 4 * tgv) * NC; \
        _Pragma("unroll") for (int i_ = 0; i_ < 4; ++i_) { rv[i_] = *(const unsigned*)vp_; vp_ += NC; } } \
    else { _Pragma("unroll") for (int i_ = 0; i_ < 4; ++i_) rv[i_] = 0u; } } while (0)
    LOADC(dir ? 64 : 0);
#pragma nounroll
    for (int step = 0; step < 65; ++step) {
        const int c = dir ? 64 - step : step;
        const long tok0 = c ? (long)b * SEQ + 64 * (c - 1) : (long)NREAL + 16 * b; const int nvalid = c ? 64 : 16;
        float ka[8], kb[8], pa[8], pb[8];
#pragma unroll
        for (int i = 0; i < 8; ++i) { ka[i] = blo(rk[i]); kb[i] = bhi(rk[i]); }
        { float xa = 1.f, xb = 1.f;
          if (dir == 0) {
#pragma unroll
              for (int i = 0; i < 8; ++i) { xa *= 1.0f - ka[i]; xb *= 1.0f - kb[i]; pa[i] = xa; pb[i] = xb; } }
          else {
#pragma unroll
              for (int i = 7; i >= 0; --i) { xa *= 1.0f - ka[i]; xb *= 1.0f - kb[i]; pa[i] = xa; pb[i] = xb; } }
          *(f32x2*)(TOT + seg * 128 + 2 * cp) = (f32x2){xa, xb}; }
        LBAR();
        {
            f32x2 Ts[8];
#pragma unroll
            for (int s_ = 0; s_ < 8; ++s_) Ts[s_] = *(const f32x2*)(TOT + s_ * 128 + 2 * cp);
            const f32x2 lo4 = (Ts[0] * Ts[1]) * (Ts[2] * Ts[3]), hi4 = (Ts[4] * Ts[5]) * (Ts[6] * Ts[7]);
            const f32x2 one = {1.f, 1.f};
            f32x2 cs, eref, erest;
            if (dir == 0) {
                eref = lo4; erest = hi4;
                if (seg <= 3) { f32x2 m = one;
#pragma unroll
                    for (int s_ = 0; s_ < 4; ++s_) m = m * (s_ >= seg ? Ts[s_] : one);
                    cs.x = __builtin_amdgcn_rcpf(m.x); cs.y = __builtin_amdgcn_rcpf(m.y); }
                else { f32x2 m = one;
#pragma unroll
                    for (int s_ = 4; s_ < 7; ++s_) m = m * (s_ < seg ? Ts[s_] : one);
                    cs = m; }
            } else {
                eref = hi4; erest = lo4;
                if (seg >= 4) { f32x2 m = one;
#pragma unroll
                    for (int s_ = 4; s_ < 8; ++s_) m = m * (s_ <= seg ? Ts[s_] : one);
                    cs.x = __builtin_amdgcn_rcpf(m.x); cs.y = __builtin_amdgcn_rcpf(m.y); }
                else { f32x2 m = one;
#pragma unroll
                    for (int s_ = 1; s_ < 4; ++s_) m = m * (s_ > seg ? Ts[s_] : one);
                    cs = m; }
            }
            float kha[8], khb[8];
#pragma unroll
            for (int i = 0; i < 8; ++i) {
                const float Ra = pa[i] * cs.x, Rb = pb[i] * cs.y;
                const float qa = blo(rq[i]), qb_ = bhi(rq[i]);
                const float ia = __builtin_amdgcn_rcpf(Ra), ib = __builtin_amdgcn_rcpf(Rb);
                const float qra = qa * Ra, qrb = qb_ * Rb, kia = ka[i] * ia, kib = kb[i] * ib;
                const int o_ = (8 * seg + i) * 136 + 2 * cp;
                *(unsigned*)(QT + o_) = pk2_bf(qra, qrb);
                *(unsigned*)(QI + o_) = pk2(qra * eref.x, qrb * eref.y);
                *(unsigned*)(KT + o_) = pk2_bf(kia, kib);
                kha[i] = kia * erest.x; khb[i] = kib * erest.y;
            }
            u32x4 w0, w1;
            w0.x = pk2(kha[0], kha[1]); w0.y = pk2(kha[2], kha[3]); w0.z = pk2(kha[4], kha[5]); w0.w = pk2(kha[6], kha[7]);
            w1.x = pk2(khb[0], khb[1]); w1.y = pk2(khb[2], khb[3]); w1.z = pk2(khb[4], khb[5]); w1.w = pk2(khb[6], khb[7]);
            *(u32x4*)(KHT + (2 * cp) * 72 + 8 * seg) = w0; *(u32x4*)(KHT + (2 * cp + 1) * 72 + 8 * seg) = w1;
            if (seg == 0) *(f32x2*)(DVv + 2 * cp) = lo4 * hi4;
            u32x2 va, vb;
            va.x = (rv[0] & 0xffffu) | (rv[1] << 16); va.y = (rv[2] & 0xffffu) | (rv[3] << 16);
            vb.x = (rv[0] >> 16) | (rv[1] & 0xffff0000u); vb.y = (rv[2] >> 16) | (rv[3] & 0xffff0000u);
            *(u32x2*)(VT + (2 * vp) * 72 + 4 * tgv) = va; *(u32x2*)(VT + (2 * vp + 1) * 72 + 4 * tgv) = vb;
        }
        if (step + 1 < 65 && !(dry & 2)) LOADC(dir ? 63 - step : step + 1);
        LBAR();
        if (wid < 4) {
            const int a = wid >> 1, sb = wid & 1;
            f32x16 p = {};
            const bf16_t* kp = KT + (32 * sb + r32) * 136 + 8 * hi; const bf16_t* qp = QT + (32 * a + r32) * 136 + 8 * hi;
#pragma unroll
            for (int kk = 0; kk < 8; ++kk) p = __builtin_amdgcn_mfma_f32_32x32x16_bf16(*(const bf16x8*)(kp + 16 * kk), *(const bf16x8*)(qp + 16 * kk), p, 0, 0, 0);
            const int t = 32 * a + r32;
#pragma unroll
            for (int r4 = 0; r4 < 4; ++r4) {
                const int s0 = 32 * sb + 8 * r4 + 4 * hi; float v[4];
#pragma unroll
                for (int e = 0; e < 4; ++e) { const int s_ = s0 + e; const bool keep = dir == 0 ? (s_ <= t) : (s_ >= t); v[e] = keep ? p[4 * r4 + e] : 0.f; }
                u32x2 w; w.x = pk2(v[0], v[1]); w.y = pk2(v[2], v[3]);
                *(u32x2*)(AS + t * 72 + s0) = w;
            }
        } else {
            const int a = (wid - 4) >> 1, j = (wid - 4) & 1;
            oacc = f32x16{};
            const bf16_t* qp = QI + (32 * a + r32) * 136 + 8 * hi; const bf16_t* sp = SB + cur * 8704 + (32 * j + r32) * 136 + 8 * hi;
#pragma unroll
            for (int kk = 0; kk < 8; ++kk) oacc = mfma32(*(const bf16x8*)(qp + 16 * kk), *(const bf16x8*)(sp + 16 * kk), oacc);
        }
        {
            const int i = wid >> 1, j = wid & 1;
#pragma unroll
            for (int r = 0; r < 16; ++r) Sacc[r] *= DVv[32 * i + crow(r, hi)];
            const bf16_t* ap = KHT + (32 * i + r32) * 72 + 8 * hi; const bf16_t* vp = VT + (32 * j + r32) * 72 + 8 * hi;
#pragma unroll
            for (int kk = 0; kk < 4; ++kk) Sacc = mfma32(*(const bf16x8*)(ap + 16 * kk), *(const bf16x8*)(vp + 16 * kk), Sacc);
            bf16_t* sbn = SB + (cur ^ 1) * 8704 + (32 * j + r32) * 136 + 32 * i + 4 * hi;
#pragma unroll
            for (int r4 = 0; r4 < 4; ++r4) { u32x2 w; w.x = pk2(Sacc[4 * r4], Sacc[4 * r4 + 1]); w.y = pk2(Sacc[4 * r4 + 2], Sacc[4 * r4 + 3]); *(u32x2*)(sbn + 8 * r4) = w; }
        }
        LBAR();
        if (wid >= 4) {
            const int a = (wid - 4) >> 1, j = (wid - 4) & 1;
            const bf16_t* ap = AS + (32 * a + r32) * 72 + 8 * hi; const bf16_t* vp = VT + (32 * j + r32) * 72 + 8 * hi;
#pragma unroll
            for (int kk = 0; kk < 4; ++kk) oacc = mfma32(*(const bf16x8*)(ap + 16 * kk), *(const bf16x8*)(vp + 16 * kk), oacc);
            bf16_t* ost = QT + (wid - 4) * 1280;
#pragma unroll
            for (int r = 0; r < 16; ++r) ost[crow(r, hi) * 40 + r32] = f2b(oacc[r]);
            asm volatile("s_waitcnt lgkmcnt(0)" ::: "memory");
#pragma unroll
            for (int i = 0; i < 2; ++i) {
                const int pc = lane + 64 * i, row = pc >> 2, sg = pc & 3;
                const u32x4 w = *(const u32x4*)(ost + row * 40 + sg * 8);
                if (32 * a + row < nvalid && !(dry & 1)) *(u32x4*)(OUT + (size_t)(tok0 + 32 * a + row) * DM + h * 128 + vs * 64 + 32 * j + sg * 8) = w;
            }
        }
        cur ^= 1;
    }
    __syncthreads();
#undef LOADC
}

__device__ __forceinline__ void hgrn_finalize(const Params& P, int dry = 0) {
    const int tid = otid(), lane = tid & 63, wid = tid >> 6;
    const bf16_t* O = (const bf16_t*)P.out; const bf16_t* Z1 = (const bf16_t*)(P.ws + WS_Z1); bf16_t* Y = (bf16_t*)(P.ws + WS_Y);
    const int col = (lane >> 3) * 128 + (lane & 7) * 16;
    float og[16];
#pragma unroll
    for (int e = 0; e < 16; ++e) og[e] = P.c_o_gain[col + e];
    const int nw = gridDim.x * 8, w0 = blockIdx.x * 8 + wid;
    for (int row = w0; row < T; row += 2 * nw) {
        const int rowb = row + nw; const bool hasb = rowb < T; const int rb = hasb ? rowb : row;
        u32x4 oa[2], ya[2], ga[2], ob[2], yb[2], gb[2];
#pragma unroll
        for (int i = 0; i < 2; ++i) {
            oa[i] = *(const u32x4*)(O + (size_t)row * DM + col + 8 * i); ya[i] = *(const u32x4*)(Y + (size_t)row * DM + col + 8 * i); ga[i] = *(const u32x4*)(Z1 + (size_t)row * NC + 4096 + col + 8 * i);
            ob[i] = *(const u32x4*)(O + (size_t)rb * DM + col + 8 * i); yb[i] = *(const u32x4*)(Y + (size_t)rb * DM + col + 8 * i); gb[i] = *(const u32x4*)(Z1 + (size_t)rb * NC + 4096 + col + 8 * i);
        }
#pragma unroll
        for (int it = 0; it < 2; ++it) {
            float o[16], g[16];
#pragma unroll
            for (int i = 0; i < 2; ++i) {
                const u32x4 ow = it ? ob[i] : oa[i], yw = it ? yb[i] : ya[i], gw = it ? gb[i] : ga[i];
                o[8 * i + 0] = blo(ow.x) + blo(yw.x); o[8 * i + 1] = bhi(ow.x) + bhi(yw.x); o[8 * i + 2] = blo(ow.y) + blo(yw.y); o[8 * i + 3] = bhi(ow.y) + bhi(yw.y);
                o[8 * i + 4] = blo(ow.z) + blo(yw.z); o[8 * i + 5] = bhi(ow.z) + bhi(yw.z); o[8 * i + 6] = blo(ow.w) + blo(yw.w); o[8 * i + 7] = bhi(ow.w) + bhi(yw.w);
                g[8 * i + 0] = blo(gw.x); g[8 * i + 1] = bhi(gw.x); g[8 * i + 2] = blo(gw.y); g[8 * i + 3] = bhi(gw.y); g[8 * i + 4] = blo(gw.z); g[8 * i + 5] = bhi(gw.z); g[8 * i + 6] = blo(gw.w); g[8 * i + 7] = bhi(gw.w);
            }
            float ss = 0.f;
#pragma unroll
            for (int e = 0; e < 16; ++e) ss += o[e] * o[e];
            ss += __shfl_xor(ss, 1); ss += __shfl_xor(ss, 2); ss += __shfl_xor(ss, 4);
            const float rs = rsqrtf(ss * (1.0f / 128.0f) + EPS);
            if (!dry && (it == 0 || hasb)) {
                bf16_t* yp = Y + (size_t)(it ? rb : row) * DM + col;
#pragma unroll
                for (int i = 0; i < 2; ++i) {
                    u32x4 w;
                    w.x = pk2(o[8 * i + 0] * rs * og[8 * i + 0] * g[8 * i + 0], o[8 * i + 1] * rs * og[8 * i + 1] * g[8 * i + 1]);
                    w.y = pk2(o[8 * i + 2] * rs * og[8 * i + 2] * g[8 * i + 2], o[8 * i + 3] * rs * og[8 * i + 3] * g[8 * i + 3]);
                    w.z = pk2(o[8 * i + 4] * rs * og[8 * i + 4] * g[8 * i + 4], o[8 * i + 5] * rs * og[8 * i + 5] * g[8 * i + 5]);
                    w.w = pk2(o[8 * i + 6] * rs * og[8 * i + 6] * g[8 * i + 6], o[8 * i + 7] * rs * og[8 * i + 7] * g[8 * i + 7]);
                    *(u32x4*)(yp + 8 * i) = w;
                }
            }
        }
    }
}

__device__ __forceinline__ void fast_barrier(unsigned* bar, unsigned gen) {
    asm volatile("s_waitcnt vmcnt(0) lgkmcnt(0)" ::: "memory");
    __syncthreads();
    if (threadIdx.x == 0) {
        const unsigned g = blockIdx.x >> 5, ng = (gridDim.x + 31) >> 5;
        const unsigned gsz = (g + 1) * 32 <= gridDim.x ? 32u : gridDim.x - g * 32;
        __builtin_amdgcn_fence(__ATOMIC_RELEASE, "agent");
        asm volatile("s_waitcnt vmcnt(0)" ::: "memory");
        if (__hip_atomic_fetch_add(bar + 64 * g, 1u, __ATOMIC_RELAXED, __HIP_MEMORY_SCOPE_AGENT) + 1u == gsz * gen) {
            if (__hip_atomic_fetch_add(bar + 512, 1u, __ATOMIC_RELAXED, __HIP_MEMORY_SCOPE_AGENT) + 1u == ng * gen) {
                for (unsigned i = 0; i < ng; ++i) __hip_atomic_store(bar + 1024 + 64 * i, gen, __ATOMIC_RELAXED, __HIP_MEMORY_SCOPE_AGENT);
            }
        }
        while (__hip_atomic_load(bar + 1024 + 64 * g, __ATOMIC_RELAXED, __HIP_MEMORY_SCOPE_AGENT) < gen) __builtin_amdgcn_s_sleep(1);
        __builtin_amdgcn_fence(__ATOMIC_ACQUIRE, "agent");
        asm volatile("s_waitcnt vmcnt(0)" ::: "memory");
    }
    __syncthreads();
}
#ifdef REP_SYNC
#define GSYNC() do { ++nbar; fast_barrier(barw, nbar); ++nbar; fast_barrier(barw, nbar); } while (0)
#else
#define GSYNC() do { ++nbar; fast_barrier(barw, nbar); } while (0)
#endif
__global__ void __launch_bounds__(512) fwd_megakernel(Params P) {
    extern __shared__ __attribute__((aligned(16))) unsigned char lds[];
    cg::grid_group grid = cg::this_grid();
    PG8_LAS unsigned char* lds3 = (PG8_LAS unsigned char*)lds;
    unsigned char* ws = P.ws;
    const int G = gridDim.x, bx = blockIdx.x;
    float* rowss = (float*)(ws + WS_ROWSS);
    bf16_t* HB = (bf16_t*)(ws + WS_HB); bf16_t* Y = (bf16_t*)(ws + WS_Y);
    unsigned* barw = (unsigned*)(ws + WS_BAR); unsigned nbar = 0;

#ifndef REP_P0
#define REP_P0 1
#endif
#ifndef REP_ATTN
#define REP_ATTN 1
#endif
#ifndef REP_SCAN
#define REP_SCAN 1
#endif
#ifndef REP_FOUR
#define REP_FOUR 1
#endif
#ifndef REP_UP
#define REP_UP 1
#endif
#ifndef REP_META
#define REP_META 1
#endif
#ifndef REP_IN
#define REP_IN 1
#endif
#ifndef REP_HG
#define REP_HG 1
#endif
#ifndef SCAN_DRY
#define SCAN_DRY 0
#endif
#pragma nounroll
    for (int rep = 0; rep < REP_P0; ++rep) { p0_prologue(P, lds); if (rep + 1 < REP_P0) GSYNC(); }
    asm volatile("s_waitcnt vmcnt(0)" ::: "memory"); grid.sync();

#pragma nounroll
    for (int layer = 0; layer < 2; ++layer) {
        if (layer == 0) {
            { pg8::Gemm g{(const bf16_t*)(ws + W_UCS), HB, 512, TP, DM}; pg8::StaticOrder S; S.init(512, TP, G, bx);
              EpiUcs E{(bf16_t*)(ws + WS_UCST), rowss};
#ifndef NO_G_UCS
              for (int rep = 0; rep < REP_IN; ++rep)
              pg8::gemm_phase<EpiUcs, pg8::StaticOrder, true, true>(lds3, g, S, E);
#endif
            }
            { pg8::Gemm g{HB, (const bf16_t*)(ws + W_QKV), TP, NQKV, DM}; pg8::StaticOrder S; S.init(TP, NQKV, G, G - 1 - bx);
              EpiAct<0> E{(bf16_t*)(ws + WS_ZQ), NQKV, rowss};
#ifndef NO_G_A0
              for (int rep = 0; rep < REP_IN; ++rep)
              pg8::gemm_phase<EpiAct<0>, pg8::StaticOrder, true, true>(lds3, g, S, E);
#endif
            }
            if (bx >= 2 && bx < 123) gen_adft(P, bx - 2, 121);
            GSYNC();
#ifdef REP_EW
            qk_norm_rope(P, (int)(P.c_lb != nullptr));
#endif
            qk_norm_rope(P);
            GSYNC();
#pragma nounroll
            for (int rep = 0; rep < REP_ATTN; ++rep)
            for (int u = bx; u < NB * 6 * 16 + 16; u += G) {
                int b, h, qb;
                if (u < NB * 96) { b = bx & 7; const int ul = (bx >> 3) + 32 * (u >> 8); h = ul >> 4; qb = ul & 15; } else { const int m = u - NB * 96; b = m & 7; h = m >> 3; qb = 16; }
#ifndef NO_ATTN
                att::attn_unit((const bf16_t*)(ws + WS_ZQ), Y, b, h, qb, (char*)lds);
#endif
            }
            if (bx >= 152) weight_jobs(P, lds, 1, 8, bx - 152, G - 152);
            { pg8::Gemm g{(const bf16_t*)(ws + WS_ADFT), (const bf16_t*)(ws + WS_UCST), MF, 2048, KF}; pg8::StaticOrder S; S.init(MF, 2048, 136, bx - 16);
              EpiFour E{Y};
#ifndef NO_G_FOUR
              if (bx >= 16 && bx < 152)
#pragma nounroll
              for (int rep = 0; rep < REP_FOUR; ++rep)
              pg8::gemm_phase<EpiFour, pg8::StaticOrder, true, true>(lds3, g, S, E);
#endif
            }
            GSYNC();
        } else {
            { pg8::Gemm g{HB, (const bf16_t*)(ws + W_C), NREAL, NC, DM}; pg8::StaticOrder S; S.init(NREAL, NC, G, bx);
              EpiHgrn E{(bf16_t*)(ws + WS_Z1), rowss + 2 * (size_t)TP, (const float*)(ws + WS_LB)};
#ifndef NO_G_HGRN
              for (int rep = 0; rep < REP_HG; ++rep)
              pg8::gemm_phase<EpiHgrn, pg8::StaticOrder, true, true>(lds3, g, S, E);
#endif
            }
            { MetaHgrn E{(bf16_t*)(ws + WS_Z1), rowss + 2 * (size_t)TP, (const float*)(ws + WS_LB)};
              for (int rep = 0; rep < REP_META; ++rep) meta_gemm(HB + (size_t)NREAL * DM, DM, (const bf16_t*)(ws + W_C), DM, NC, E, lds); }
            GSYNC();
#pragma nounroll
            for (int rep = 0; rep < REP_SCAN; ++rep)
            for (int u = bx; u < NB * 8 * 4; u += G) {
                const int slot = u >> 3, grp = (u & 7) * 8 + (slot >> 2); const int b = grp >> 3, h = grp & 7, vs = (slot >> 1) & 1, dir = slot & 1;
#ifndef NO_SCAN
                scan_unit((const bf16_t*)(ws + WS_Z1), dir ? Y : (bf16_t*)P.out, b, h, dir, vs, lds, rep + 1 < REP_SCAN ? SCAN_DRY : 0);
#endif
            }
            GSYNC();
#if defined(STOP_AT) && STOP_AT == 5
            { const int tid = otid(); for (long i = (long)bx * 512 + tid; i < (long)NB * SEQ * DM; i += (long)G * 512) P.out[i] = b2f(HB[i]); return; }
#endif
#ifdef REP_EW
            hgrn_finalize(P, (int)(P.c_lb != nullptr));
#endif
            hgrn_finalize(P);
            GSYNC();
#if defined(STOP_AT) && STOP_AT == 6
            { const int tid = otid(); for (long i = (long)bx * 512 + tid; i < (long)NB * SEQ * DM; i += (long)G * 512) P.out[i] = b2f(Y[i]); return; }
#endif
        }
#if defined(STOP_AT) && STOP_AT == 1
        if (layer == 0) return;
#endif
#if defined(STOP_AT) && STOP_AT == 4
        if (layer == 1) return;
#endif
        int bxl = bx, Gl = G; asm volatile("" : "+s"(bxl), "+s"(Gl));
        const int MG = NREAL;
        { pg8::Gemm g{Y, (const bf16_t*)(ws + W_O0 + (size_t)layer * 2 * MiB), MG, DM, DM}; pg8::StaticOrder S; S.init(MG, DM, Gl, bxl);
          EpiRes E{HB, rowss + (size_t)(1 + 2 * layer) * TP};
#ifndef NO_G_RES
          pg8::gemm_phase<EpiRes, pg8::StaticOrder, true, true>(lds3, g, S, E);
#endif
            }
        if (layer == 0) { MetaRes E{HB, rowss + (size_t)TP}; meta_gemm(Y + (size_t)NREAL * DM, DM, (const bf16_t*)(ws + W_O0), DM, DM, E, lds); }
        GSYNC();
#if defined(STOP_AT) && STOP_AT == 2
        if (layer == 0) return;
#endif
        { pg8::Gemm g{HB, (const bf16_t*)(ws + W_1_0 + (size_t)layer * 8 * MiB), MG, DFF, DM}; pg8::StaticOrder S; S.init(MG, DFF, Gl, bxl);
          EpiAct<1> E{(bf16_t*)(ws + WS_HID), DFF, rowss + (size_t)(1 + 2 * layer) * TP};
#ifndef NO_G_A1
#pragma nounroll
          for (int rep = 0; rep < REP_UP; ++rep)
          pg8::gemm_phase<EpiAct<1>, pg8::StaticOrder, true, true>(lds3, g, S, E);
#endif
            }
        if (layer == 0) { MetaUp E{(bf16_t*)(ws + WS_HID), rowss + (size_t)TP}; for (int rep = 0; rep < REP_META; ++rep) meta_gemm(HB + (size_t)NREAL * DM, DM, (const bf16_t*)(ws + W_1_0), DM, DFF, E, lds); }
        GSYNC();
        { pg8::Gemm g{(const bf16_t*)(ws + WS_HID), (const bf16_t*)(ws + W_2_0 + (size_t)layer * 8 * MiB), MG, DM, DFF}; pg8::StaticOrder S; S.init(MG, DM, Gl, bxl);
          EpiRes E{HB, rowss + (size_t)(2 + 2 * layer) * TP};
#ifdef REP_DOWN
          { EpiDummy ED{(float*)P.c_lb == nullptr ? (float*)(ws + WS_Y) : nullptr}; pg8::gemm_phase<EpiDummy, pg8::StaticOrder, true, true>(lds3, g, S, ED); }
#endif
#ifndef NO_G_RES
          pg8::gemm_phase<EpiRes, pg8::StaticOrder, true, true>(lds3, g, S, E);
#endif
            }
        if (layer == 0) { MetaRes E{HB, rowss + 2 * (size_t)TP}; meta_gemm((const bf16_t*)(ws + WS_HID) + (size_t)NREAL * DFF, DFF, (const bf16_t*)(ws + W_2_0), DFF, DM, E, lds); }
        GSYNC();
#if defined(STOP_AT) && STOP_AT == 3
        if (layer == 0) return;
#endif
    }
    const int tid = otid(), lane = tid & 63, wid = tid >> 6;
#ifdef REP_EW
    for (int rep = 0; rep < 2; ++rep)
#endif
    for (int orow = bx * 8 + wid; orow < NB * SEQ; orow += G * 8) {
        const float rs = rstd_of(rowss[(size_t)4 * TP + orow]);
        float* hp = P.out + (size_t)orow * DM; const bf16_t* hb = HB + (size_t)orow * DM;
#pragma unroll
        for (int i = 0; i < 4; ++i) {
            const int col = i * 256 + lane * 4;
            const u32x2 hw = *(const u32x2*)(hb + col); const f32x4 g = *(const f32x4*)(P.final_gain + col);
            const f32x4 v = {blo(hw.x), bhi(hw.x), blo(hw.y), bhi(hw.y)};
            *(f32x4*)(hp + col) = v * rs * g;
        }
    }
}

extern "C" void kernel_launch(void* const* d_in, const int* in_sizes, int n_in, void* d_out, int out_size, void* d_ws, size_t ws_size, hipStream_t stream) {
    static int grid_blocks = 0;
    if (grid_blocks == 0) {
        if (n_in != 15 || out_size != NB * SEQ * DM || ws_size < WS_NEED) { fprintf(stderr, "kernel_launch: unexpected shapes (n_in %d out %d ws %zu, need %zu)\n", n_in, out_size, ws_size, (size_t)WS_NEED); grid_blocks = -1; return; }
        int dev = 0, cus = 0, per_cu = 0;
        hipGetDevice(&dev);
        hipDeviceGetAttribute(&cus, hipDeviceAttributeMultiprocessorCount, dev);
        if (hipFuncSetAttribute((const void*)fwd_megakernel, hipFuncAttributeMaxDynamicSharedMemorySize, LDS_BYTES) != hipSuccess) { fprintf(stderr, "kernel_launch: hipFuncSetAttribute failed\n"); grid_blocks = -1; return; }
        if (hipOccupancyMaxActiveBlocksPerMultiprocessor(&per_cu, (const void*)fwd_megakernel, 512, LDS_BYTES) != hipSuccess || per_cu < 1) { fprintf(stderr, "kernel_launch: occupancy query gave %d\n", per_cu); per_cu = 1; }
        (void)hipGetLastError();
        if (cus < 256) { fprintf(stderr, "kernel_launch: needs 256 CUs, found %d\n", cus); grid_blocks = -1; return; }
        grid_blocks = 256;
    }
    if (grid_blocks < 0) return;
    Params p{};
    p.x = (const float*)d_in[0]; p.meta = (const float*)d_in[1]; p.mix_gain = (const float*)d_in[2]; p.ab_w_in = (const float*)d_in[3];
    p.ab_q_gain = (const float*)d_in[4]; p.ab_k_gain = (const float*)d_in[5]; p.ab_w_out = (const float*)d_in[6]; p.c_w_in = (const float*)d_in[7];
    p.c_lb = (const float*)d_in[8]; p.c_o_gain = (const float*)d_in[9]; p.c_w_out = (const float*)d_in[10]; p.mlp_gain = (const float*)d_in[11];
    p.mlp_w1 = (const float*)d_in[12]; p.mlp_w2 = (const float*)d_in[13]; p.final_gain = (const float*)d_in[14];
    p.out = (float*)d_out; p.ws = (unsigned char*)d_ws;
    if (hipMemsetAsync((char*)d_ws + WS_BAR, 0, 8192, stream) != hipSuccess) { fprintf(stderr, "kernel_launch: memset failed\n"); return; }
    void* args[] = {&p};
    hipError_t e = hipLaunchCooperativeKernel((const void*)fwd_megakernel, dim3(grid_blocks), dim3(512), args, LDS_BYTES, stream);
    if (e != hipSuccess) fprintf(stderr, "kernel_launch: cooperative launch failed: %s (grid %d)\n", hipGetErrorString(e), grid_blocks);
}
```

```cpp
#include <hip/hip_runtime.h>
#include <hip/hip_cooperative_groups.h>
#include <hip/hip_bf16.h>
#include <cstdio>
#include <cstdint>
namespace cg = cooperative_groups;
namespace pg8 {
#define PG8_LAS __attribute__((address_space(3)))
typedef unsigned short bf16_t;
typedef short bf16x8 __attribute__((ext_vector_type(8)));
typedef _Float16 f16x8 __attribute__((ext_vector_type(8)));
typedef float f32x4 __attribute__((ext_vector_type(4)));
typedef unsigned u32x4 __attribute__((ext_vector_type(4)));
constexpr int BM = 256, BK = 64, HALF = 128, HTB = HALF * BK * 2  , STAGE_BYTES = 8 * HTB, NXCD = 8, WGM = 4;

__host__ __device__ __forceinline__ int lds_byte(int r, int c) { const int st = (r >> 4) * 2 + (c >> 5), rr = r & 15, cc = c & 31, ob = rr * 64 + cc * 2; return st * 1024 + (ob ^ (((ob >> 9) & 1) << 5)); }
__host__ __device__ __forceinline__ void stage_rc(int b, int& R, int& C) { const int st = b / 1024, sb = b % 1024, swz = sb ^ (((sb >> 9) & 1) << 5); R = (st >> 1) * 16 + swz / 64; C = (st & 1) * 32 + (swz % 64) / 2; }
__host__ __device__ __forceinline__ int perm32(int rho) { const int n = rho >> 4, i = rho & 15; return 8 * (i >> 2) + 4 * n + (i & 3); }

struct Unit { int pm, pn; };
struct Gemm { const bf16_t* A; const bf16_t* Bt; int M, N, K; };

struct StaticOrder {
    int nM, nN, nwg, G, c;
    __host__ __device__ void init(int M, int N, int G_, int c_) { nM = M / BM; nN = N / BM; nwg = nM * nN; G = G_; c = c_; }
    __host__ __device__ bool next(int i, Unit& u) const {
        const long L = (long)i * G + c; if (L >= nwg) return false;
        int wgid = (int)L; { const int q = nwg / NXCD, r = nwg % NXCD, xcd = wgid % NXCD, off = wgid / NXCD; wgid = (xcd < r ? xcd * (q + 1) : r * (q + 1) + (xcd - r) * q) + off; }
        const int nig = WGM * nN, gid = wgid / nig, fm = gid * WGM, gsz = (nM - fm) < WGM ? (nM - fm) : WGM;
        u.pm = fm + ((wgid % nig) % gsz); u.pn = (wgid % nig) / gsz; return true;
    }
    __device__ __forceinline__ void a_ready(const Unit&) const {}
    __device__ __forceinline__ void done(const Unit&) const {}
};

__device__ __forceinline__ unsigned cvt_pk_bf16(float lo, float hi) { unsigned r; asm volatile("v_cvt_pk_bf16_f32 %0, %1, %2" : "=v"(r) : "v"(lo), "v"(hi)); return r; }
typedef float f32x2 __attribute__((ext_vector_type(2)));
template <class Epi, class Sched, bool ALIGN_EPI = false, bool SP2 = false>
__device__ __forceinline__ void gemm_phase(PG8_LAS unsigned char* lds, const Gemm g, const Sched& S, const Epi& E) {
    int tid_o = threadIdx.x; asm volatile("" : "+v"(tid_o));
    const int tid = tid_o, wid = __builtin_amdgcn_readfirstlane(tid >> 6), lane = tid & 63, wr = wid >> 2, wc = wid & 3, fr = lane & 15, fq = lane >> 4;
    const int K = g.K, nt = K / BK;
    unsigned voffA[2], voffB[2];
#pragma unroll
    for (int i = 0; i < 2; ++i) { int R, C; stage_rc(tid * 16 + i * 8192, R, C); const int Rb = Epi::PERM ? ((R & ~31) + perm32(R & 31)) : R;
        voffA[i] = (unsigned)(R * K + C) * 2u; voffB[i] = (unsigned)(Rb * K + C) * 2u; }
    const size_t kstep = (size_t)(BK * 2);
    const size_t hstep = (size_t)HALF * K * 2;
    const size_t tstep = 2 * hstep;
    const unsigned ldsw = (unsigned)wid * 1024u;
    const int aoff = lds_byte(wr * 64 + fr, fq * 8), boff = lds_byte(wc * 32 + fr, fq * 8);
#define PG8_SA(b, h) (((b) * 2 + (h)) * HTB)
#define PG8_SB(b, h) ((4 + (b) * 2 + (h)) * HTB)
#define PG8_STAGE(bufoff, gbase, voff) do { _Pragma("unroll") for (int _i = 0; _i < 2; ++_i) \
        __builtin_amdgcn_global_load_lds((const unsigned*)((const char*)(gbase) + (voff)[_i]), (PG8_LAS unsigned*)(lds + (bufoff) + ldsw + _i * 8192), 16, 0, 0); } while (0)
#define PG8_LDA(dst, b, h) do { _Pragma("unroll") for (int m = 0; m < 4; ++m) _Pragma("unroll") for (int k = 0; k < 2; ++k) dst[m][k] = *(const PG8_LAS bf16x8*)(lds + PG8_SA(b, h) + aoff + m * 2048 + k * 1024); } while (0)
#define PG8_LDB(dst, b, h) do { _Pragma("unroll") for (int n = 0; n < 2; ++n) _Pragma("unroll") for (int k = 0; k < 2; ++k) dst[n][k] = *(const PG8_LAS bf16x8*)(lds + PG8_SB(b, h) + boff + n * 2048 + k * 1024); } while (0)
#define PG8_MMA(ai, bj, At, Bt) do { __builtin_amdgcn_s_setprio(1); _Pragma("unroll") for (int m = 0; m < 4; ++m) _Pragma("unroll") for (int n = 0; n < 2; ++n) _Pragma("unroll") for (int k = 0; k < 2; ++k) \
        acc[ai][bj][m][n] = __builtin_amdgcn_mfma_f32_16x16x32_f16(__builtin_bit_cast(pg8::f16x8, Bt[n][k]), __builtin_bit_cast(pg8::f16x8, At[m][k]), acc[ai][bj][m][n], 0, 0, 0); __builtin_amdgcn_s_setprio(0); } while (0)
#define PG8_WAIT_V(n) asm volatile("s_waitcnt vmcnt(" #n ")" ::: "memory")
#define PG8_WAIT_L(n) asm volatile("s_waitcnt lgkmcnt(" #n ")" ::: "memory")
#define PG8_BAR __builtin_amdgcn_s_barrier()
#define PG8_SCHED __builtin_amdgcn_sched_barrier(0)
    Unit cur, nxt; int ui = 0;
    if (!S.next(0, cur)) return;
    f32x4 acc[2][2][4][2];
#pragma unroll
    for (int a = 0; a < 2; ++a)
#pragma unroll
        for (int b = 0; b < 2; ++b)
#pragma unroll
            for (int m = 0; m < 4; ++m)
#pragma unroll
                for (int n = 0; n < 2; ++n) acc[a][b][m][n] = (f32x4){0.f, 0.f, 0.f, 0.f};
    bf16x8 At[4][2], B0[2][2], B1[2][2];
    const char* cA = (const char*)g.A + (size_t)cur.pm * tstep; const char* cB = (const char*)g.Bt + (size_t)cur.pn * tstep;
    S.a_ready(cur);
    if constexpr (SP2) {
        PG8_STAGE(PG8_SB(0, 0), cB, voffB); PG8_STAGE(PG8_SB(0, 1), cB + hstep, voffB); PG8_STAGE(PG8_SA(0, 0), cA, voffA); PG8_STAGE(PG8_SA(0, 1), cA + hstep, voffA);
        if (wr == 1) PG8_BAR;
        PG8_WAIT_V(2); PG8_BAR;
        PG8_STAGE(PG8_SB(1, 0), cB + kstep, voffB); PG8_STAGE(PG8_SA(1, 0), cA + kstep, voffA); PG8_STAGE(PG8_SB(1, 1), cB + hstep + kstep, voffB);
        PG8_WAIT_V(6); PG8_BAR;
    } else {
        PG8_STAGE(PG8_SB(0, 0), cB, voffB); PG8_STAGE(PG8_SA(0, 0), cA, voffA); PG8_STAGE(PG8_SB(0, 1), cB + hstep, voffB); PG8_STAGE(PG8_SA(0, 1), cA + hstep, voffA);
        if (wr == 1) PG8_BAR;
        PG8_WAIT_V(4); PG8_BAR;
        PG8_STAGE(PG8_SB(1, 0), cB + kstep, voffB); PG8_STAGE(PG8_SA(1, 0), cA + kstep, voffA); PG8_STAGE(PG8_SB(1, 1), cB + hstep + kstep, voffB);
        PG8_WAIT_V(6); PG8_BAR;
    }
    for (;;) {
        const bool has_next = S.next(ui + 1, nxt);
        const char* nA = has_next ? (const char*)g.A + (size_t)nxt.pm * tstep : cA; const char* nB = has_next ? (const char*)g.Bt + (size_t)nxt.pn * tstep : cB;
        for (int t = 0; t < nt; t += 2) {
            const bool last = (t == nt - 2);
            const char* a1 = cA + (size_t)(t + 1) * kstep;
            const char* a2 = last ? nA : cA + (size_t)(t + 2) * kstep; const char* b2 = last ? nB : cB + (size_t)(t + 2) * kstep;
            const char* a3 = a2 + kstep; const char* b3 = b2 + kstep;
            if (last && has_next) S.a_ready(nxt);
            if constexpr (SP2) {
            PG8_LDB(B0, 0, 0); PG8_LDB(B1, 0, 1); PG8_SCHED; PG8_LDA(At, 0, 0); PG8_STAGE(PG8_SA(1, 1), a1 + hstep, voffA);
            PG8_WAIT_V(8); PG8_WAIT_L(0); PG8_BAR; PG8_MMA(0, 0, At, B0); PG8_MMA(0, 1, At, B1); PG8_BAR; PG8_SCHED;
            PG8_LDA(At, 0, 1); PG8_STAGE(PG8_SB(0, 0), b2, voffB); PG8_STAGE(PG8_SB(0, 1), b2 + hstep, voffB); PG8_STAGE(PG8_SA(0, 0), a2, voffA);
            PG8_WAIT_V(8); PG8_WAIT_L(0); PG8_BAR; PG8_MMA(1, 0, At, B0); PG8_MMA(1, 1, At, B1); PG8_BAR; PG8_SCHED;
            PG8_LDB(B0, 1, 0); PG8_LDB(B1, 1, 1); PG8_SCHED; PG8_LDA(At, 1, 0); PG8_STAGE(PG8_SA(0, 1), a2 + hstep, voffA);
            PG8_WAIT_V(8); PG8_WAIT_L(0); PG8_BAR; PG8_MMA(0, 0, At, B0); PG8_MMA(0, 1, At, B1); PG8_BAR; PG8_SCHED;
            PG8_LDA(At, 1, 1); PG8_STAGE(PG8_SB(1, 0), b3, voffB); PG8_STAGE(PG8_SB(1, 1), b3 + hstep, voffB); PG8_STAGE(PG8_SA(1, 0), a3, voffA);
            PG8_WAIT_V(8); PG8_WAIT_L(0); PG8_BAR; PG8_MMA(1, 0, At, B0); PG8_MMA(1, 1, At, B1); PG8_BAR; PG8_SCHED;
            } else {
            PG8_LDB(B0, 0, 0); PG8_SCHED; PG8_LDA(At, 0, 0); PG8_STAGE(PG8_SA(1, 1), a1 + hstep, voffA);
            PG8_WAIT_L(8); PG8_BAR; PG8_WAIT_L(0); PG8_MMA(0, 0, At, B0); PG8_BAR; PG8_SCHED;
            PG8_LDB(B1, 0, 1); PG8_STAGE(PG8_SB(0, 0), b2, voffB);
            PG8_BAR; PG8_WAIT_L(0); PG8_MMA(0, 1, At, B1); PG8_BAR;
            PG8_LDA(At, 0, 1); PG8_STAGE(PG8_SA(0, 0), a2, voffA);
            PG8_BAR; PG8_WAIT_L(0); PG8_MMA(1, 0, At, B0); PG8_BAR; PG8_SCHED;
            PG8_STAGE(PG8_SB(0, 1), b2 + hstep, voffB);
            PG8_WAIT_V(6); PG8_BAR; PG8_MMA(1, 1, At, B1); PG8_BAR;
            PG8_LDB(B0, 1, 0); PG8_SCHED; PG8_LDA(At, 1, 0); PG8_STAGE(PG8_SA(0, 1), a2 + hstep, voffA);
            PG8_WAIT_L(8); PG8_BAR; PG8_WAIT_L(0); PG8_MMA(0, 0, At, B0); PG8_BAR; PG8_SCHED;
            PG8_LDB(B1, 1, 1); PG8_STAGE(PG8_SB(1, 0), b3, voffB);
            PG8_BAR; PG8_WAIT_L(0); PG8_MMA(0, 1, At, B1); PG8_BAR;
            PG8_LDA(At, 1, 1); PG8_STAGE(PG8_SA(1, 0), a3, voffA);
            PG8_BAR; PG8_WAIT_L(0); PG8_MMA(1, 0, At, B0); PG8_BAR; PG8_SCHED;
            PG8_STAGE(PG8_SB(1, 1), b3 + hstep, voffB);
            PG8_WAIT_V(6); PG8_BAR; PG8_MMA(1, 1, At, B1); PG8_BAR;
            }
        }
        if constexpr (ALIGN_EPI) { if (wr == 0) PG8_BAR; }
        if constexpr (!Epi::AFTER_DRAIN) { E(acc, cur, wr, wc, fr, fq); S.done(cur); }
        if (!has_next) break;
#pragma unroll
        for (int a = 0; a < 2; ++a)
#pragma unroll
            for (int b = 0; b < 2; ++b)
#pragma unroll
                for (int m = 0; m < 4; ++m)
#pragma unroll
                    for (int n = 0; n < 2; ++n) acc[a][b][m][n] = (f32x4){0.f, 0.f, 0.f, 0.f};
        cur = nxt; cA = nA; cB = nB; ++ui;
        if constexpr (ALIGN_EPI) { if (wr == 1) PG8_BAR; }
    }
    PG8_WAIT_V(0);
    if constexpr (!ALIGN_EPI) { if (wr == 0) PG8_BAR; }
    PG8_BAR;
    if constexpr (Epi::AFTER_DRAIN) { E.fused(acc, cur, wr, wc, fr, fq, lds, wid, lane); S.done(cur); }
#undef PG8_SA
#undef PG8_SB
#undef PG8_STAGE
#undef PG8_LDA
#undef PG8_LDB
#undef PG8_MMA
#undef PG8_WAIT_V
#undef PG8_WAIT_L
#undef PG8_BAR
#undef PG8_SCHED
}
}

typedef unsigned short bf16_t;
typedef short bf16x8 __attribute__((ext_vector_type(8)));
typedef short s16x4 __attribute__((ext_vector_type(4)));
typedef float f32x4 __attribute__((ext_vector_type(4)));
typedef float f32x16 __attribute__((ext_vector_type(16)));
typedef unsigned u32x4 __attribute__((ext_vector_type(4)));
typedef unsigned u32x2 __attribute__((ext_vector_type(2)));
#define LAS3 __attribute__((address_space(3)))

constexpr int DM = 1024, NB = 8, SEQ = 4096, LT = 4112, T = NB * LT, TP = 33024, NREAL = NB * SEQ;
constexpr int NQKV = 1280, DFF = 4096, NC = 5120;
constexpr int LK = 4160, KF = 2 * LK, MF = 4352;
constexpr float EPS = 1e-6f;
constexpr size_t MiB = 1u << 20;
constexpr size_t WS_ROWSS = 0;
constexpr size_t WS_LB = 704512;
constexpr size_t WS_BAR = 720896;
constexpr size_t WS_HMETA = 1 * MiB;
constexpr size_t W_UCS = 2 * MiB;
constexpr size_t W_QKV = W_UCS + 1 * MiB;
constexpr size_t W_O0 = W_QKV + 2560 * 1024;
constexpr size_t W_1_0 = W_O0 + 4 * MiB;
constexpr size_t W_2_0 = W_1_0 + 16 * MiB;
constexpr size_t W_C = W_2_0 + 16 * MiB;
constexpr size_t W_END = W_C + 10 * MiB;
constexpr size_t WS_HB = 52 * MiB;
constexpr size_t WS_Y = 117 * MiB;
constexpr size_t WS_BIG = 182 * MiB;
constexpr size_t WS_ZQ = WS_BIG, WS_UCST = WS_BIG + 81 * MiB, WS_ADFT = WS_BIG + 114 * MiB, WS_HID = WS_BIG, WS_Z1 = WS_BIG;
constexpr size_t WS_NEED = WS_BIG + (size_t)TP * NC * 2;
static_assert(W_END <= WS_HB && WS_HB + (size_t)TP * DM * 2 <= WS_Y && WS_Y + (size_t)TP * DM * 2 <= WS_BIG, "ws map");
static_assert(WS_ZQ + (size_t)TP * NQKV * 2 <= WS_UCST && WS_UCST + (size_t)2048 * KF * 2 <= WS_ADFT && WS_ADFT + (size_t)MF * KF * 2 <= WS_NEED, "ws map 2");
static_assert(WS_NEED <= 512 * MiB, "ws size");
constexpr int LDS_BYTES = 147456;

struct Params {
    const float* x; const float* meta; const float* mix_gain; const float* ab_w_in; const float* ab_q_gain; const float* ab_k_gain; const float* ab_w_out;
    const float* c_w_in; const float* c_lb; const float* c_o_gain; const float* c_w_out; const float* mlp_gain; const float* mlp_w1; const float* mlp_w2; const float* final_gain;
    float* out; unsigned char* ws;
};

typedef _Float16 f16x2 __attribute__((ext_vector_type(2)));
typedef _Float16 f16x8 __attribute__((ext_vector_type(8)));
typedef float f32x2 __attribute__((ext_vector_type(2)));
__device__ __forceinline__ unsigned pk2(float lo, float hi) { const f32x2 v = {lo, hi}; const f16x2 h = __builtin_convertvector(v, f16x2); return __builtin_bit_cast(unsigned, h); }
__device__ __forceinline__ bf16_t f2b(float v) { const _Float16 h = (_Float16)v; return __builtin_bit_cast(unsigned short, h); }
__device__ __forceinline__ float b2f(bf16_t v) { return (float)__builtin_bit_cast(_Float16, v); }
__device__ __forceinline__ float blo(unsigned w) { return b2f((bf16_t)(w & 0xffffu)); }
__device__ __forceinline__ float bhi(unsigned w) { return b2f((bf16_t)(w >> 16)); }
__device__ __forceinline__ unsigned pk2_bf(float lo, float hi) { unsigned r; asm volatile("v_cvt_pk_bf16_f32 %0, %1, %2" : "=v"(r) : "v"(lo), "v"(hi)); return r; }
__device__ __forceinline__ bf16_t f2bf(float v) { return (bf16_t)(pk2_bf(v, v) & 0xffffu); }
__device__ __forceinline__ f32x16 mfma32(bf16x8 a, bf16x8 b, f32x16 c) { return __builtin_amdgcn_mfma_f32_32x32x16_f16(__builtin_bit_cast(f16x8, a), __builtin_bit_cast(f16x8, b), c, 0, 0, 0); }
__device__ __forceinline__ const Params& KP() { const void* p = (const void*)__builtin_amdgcn_kernarg_segment_ptr(); asm volatile("" : "+s"(p)); return *(const Params*)p; }
__device__ __forceinline__ int otid() { int t = threadIdx.x; asm volatile("" : "+v"(t)); return t; }
__device__ __forceinline__ int crow(int r, int hi) { return (r & 3) + 8 * (r >> 2) + 4 * hi; }
__device__ __forceinline__ float wave_sum(float v) {
#pragma unroll
    for (int o = 32; o > 0; o >>= 1) v += __shfl_xor(v, o);
    return v;
}
__device__ __forceinline__ float rstd_of(float ss) { return rsqrtf(ss * (1.0f / 1024.0f) + EPS); }
template <int ACT> struct EpiAct {
    static constexpr bool PERM = true, AFTER_DRAIN = false;
    bf16_t* O; int ldc; const float* rowss;
    __device__ __forceinline__ void operator()(const f32x4 (&acc)[2][2][4][2], const pg8::Unit& u, int wr, int wc, int fr, int fq) const {
        const int row0 = u.pm * 256 + wr * 64 + fr, col0 = u.pn * 256 + wc * 32 + 8 * fq;
        float rsv[2][4];
#pragma unroll
        for (int ai = 0; ai < 2; ++ai)
#pragma unroll
            for (int m = 0; m < 4; ++m) rsv[ai][m] = rowss[row0 + ai * 128 + m * 16];
#pragma unroll
        for (int ai = 0; ai < 2; ++ai)
#pragma unroll
            for (int m = 0; m < 4; ++m) rsv[ai][m] = rstd_of(rsv[ai][m]);
#pragma unroll
        for (int ai = 0; ai < 2; ++ai)
#pragma unroll
            for (int m = 0; m < 4; ++m) {
                const int row = row0 + ai * 128 + m * 16; const float rs = rsv[ai][m];
                bf16_t* rowp = O + (size_t)row * ldc + col0;
#pragma unroll
                for (int bj = 0; bj < 2; ++bj) {
                    f32x4 v0 = acc[ai][bj][m][0] * rs, v1 = acc[ai][bj][m][1] * rs;
                    if (ACT == 1) {
#pragma unroll
                        for (int j = 0; j < 4; ++j) { float a = fmaxf(v0[j], 0.f), b = fmaxf(v1[j], 0.f); v0[j] = a * a; v1[j] = b * b; }
                    }
                    u32x4 w; w.x = pk2(v0[0], v0[1]); w.y = pk2(v0[2], v0[3]); w.z = pk2(v1[0], v1[1]); w.w = pk2(v1[2], v1[3]);
                    __builtin_nontemporal_store(w, (u32x4*)(rowp + bj * 128));
                }
            }
    }
};
struct EpiUcs {
    static constexpr bool PERM = true, AFTER_DRAIN = false;
    bf16_t* U; const float* rowss;
    __device__ __forceinline__ void operator()(const f32x4 (&acc)[2][2][4][2], const pg8::Unit& u, int wr, int wc, int fr, int fq) const {
        const int part = u.pm;
        f32x4 sv[2][2];
#pragma unroll
        for (int bj = 0; bj < 2; ++bj) { const int t0 = u.pn * 256 + bj * 128 + wc * 32 + 8 * fq; sv[bj][0] = *(const f32x4*)(rowss + t0); sv[bj][1] = *(const f32x4*)(rowss + t0 + 4); }
#pragma unroll
        for (int bj = 0; bj < 2; ++bj) {
            const int t0 = u.pn * 256 + bj * 128 + wc * 32 + 8 * fq;
            if (t0 < T) {
                int b, p; if (t0 < NREAL) { b = t0 >> 12; p = 16 + (t0 & 4095); } else { b = (t0 - NREAL) >> 4; p = (t0 - NREAL) & 15; }
                const f32x4 s0 = sv[bj][0], s1 = sv[bj][1];
                f32x4 r0, r1; r0[0] = rstd_of(s0[0]); r0[1] = rstd_of(s0[1]); r0[2] = rstd_of(s0[2]); r0[3] = rstd_of(s0[3]); r1[0] = rstd_of(s1[0]); r1[1] = rstd_of(s1[1]); r1[2] = rstd_of(s1[2]); r1[3] = rstd_of(s1[3]);
#pragma unroll
                for (int ai = 0; ai < 2; ++ai)
#pragma unroll
                    for (int m = 0; m < 4; ++m) {
                        const int c = ai * 128 + wr * 64 + m * 16 + fr;
                        const f32x4 v0 = acc[ai][bj][m][0] * r0, v1 = acc[ai][bj][m][1] * r1;
                        u32x4 w; w.x = pk2(v0[0], v0[1]); w.y = pk2(v0[2], v0[3]); w.z = pk2(v1[0], v1[1]); w.w = pk2(v1[2], v1[3]);
                        __builtin_nontemporal_store(w, (u32x4*)(U + (size_t)(b * 256 + c) * KF + part * LK + p));
                    }
            }
        }
    }
};
struct EpiFour {
    static constexpr bool PERM = true, AFTER_DRAIN = false;
    bf16_t* Y;
    __device__ __forceinline__ void operator()(const f32x4 (&acc)[2][2][4][2], const pg8::Unit& u, int wr, int wc, int fr, int fq) const {
        const int row0 = u.pm * 256 + wr * 64 + fr, col0 = wc * 32 + 8 * fq;
#pragma unroll
        for (int ai = 0; ai < 2; ++ai)
#pragma unroll
            for (int m = 0; m < 4; ++m) {
                const int lp = row0 + ai * 128 + m * 16;
                if (lp < LT) {
                    bf16_t* rowp = Y + (size_t)(lp < 16 ? NREAL + u.pn * 16 + lp : u.pn * SEQ + lp - 16) * DM + col0;
#pragma unroll
                    for (int bj = 0; bj < 2; ++bj) {
                        const f32x4 v0 = acc[ai][bj][m][0], v1 = acc[ai][bj][m][1];
                        u32x4 w; w.x = pk2(v0[0], v0[1]); w.y = pk2(v0[2], v0[3]); w.z = pk2(v1[0], v1[1]); w.w = pk2(v1[2], v1[3]);
                        __builtin_nontemporal_store(w, (u32x4*)(rowp + bj * 128));
                    }
                }
            }
    }
};
struct EpiHgrn {
    static constexpr bool PERM = true, AFTER_DRAIN = false;
    bf16_t* O; const float* rowss; const float* lb;
    template <int MODE>
    __device__ __forceinline__ void body(const f32x4 (&acc)[2][2][4][2], const float (&rsv)[2][4], const f32x4 (&lbv)[2][2], int row0, int col0) const {
#pragma unroll
        for (int ai = 0; ai < 2; ++ai)
#pragma unroll
            for (int m = 0; m < 4; ++m) {
                const int row = row0 + ai * 128 + m * 16; const float rs = rsv[ai][m];
                bf16_t* rowp = O + (size_t)row * NC + col0;
#pragma unroll
                for (int bj = 0; bj < 2; ++bj) {
                    f32x4 v[2]; v[0] = acc[ai][bj][m][0] * rs; v[1] = acc[ai][bj][m][1] * rs;
                    if (MODE != 2) {
#pragma unroll
                        for (int n = 0; n < 2; ++n)
#pragma unroll
                            for (int j = 0; j < 4; ++j) {
                                const float x = v[n][j];
                                if (MODE == 0) v[n][j] = x * __builtin_amdgcn_rcpf(1.0f + __expf(-x));
                                else v[n][j] = (1.0f - lbv[bj][n][j]) * __builtin_amdgcn_rcpf(1.0f + __expf(x));
                            }
                    }
                    u32x4 w; w.x = pk2(v[0][0], v[0][1]); w.y = pk2(v[0][2], v[0][3]); w.z = pk2(v[1][0], v[1][1]); w.w = pk2(v[1][2], v[1][3]);
                    __builtin_nontemporal_store(w, (u32x4*)(rowp + bj * 128));
                }
            }
    }
    __device__ __forceinline__ void operator()(const f32x4 (&acc)[2][2][4][2], const pg8::Unit& u, int wr, int wc, int fr, int fq) const {
        const int typ = u.pn >> 2;
        const int row0 = u.pm * 256 + wr * 64 + fr, col0 = u.pn * 256 + wc * 32 + 8 * fq;
        f32x4 lbv[2][2];
#pragma unroll
        for (int bj = 0; bj < 2; ++bj) {
            if (typ == 1 || typ == 2) { const float* lp = lb + (col0 - 1024 + bj * 128); lbv[bj][0] = *(const f32x4*)lp; lbv[bj][1] = *(const f32x4*)(lp + 4); }
            else { lbv[bj][0] = (f32x4){0.f, 0.f, 0.f, 0.f}; lbv[bj][1] = lbv[bj][0]; }
        }
        float rsv[2][4];
#pragma unroll
        for (int ai = 0; ai < 2; ++ai)
#pragma unroll
            for (int m = 0; m < 4; ++m) rsv[ai][m] = rowss[row0 + ai * 128 + m * 16];
#pragma unroll
        for (int ai = 0; ai < 2; ++ai)
#pragma unroll
            for (int m = 0; m < 4; ++m) rsv[ai][m] = rstd_of(rsv[ai][m]);
        if (typ == 3) body<2>(acc, rsv, lbv, row0, col0);
        else if (typ == 1 || typ == 2) body<1>(acc, rsv, lbv, row0, col0);
        else body<0>(acc, rsv, lbv, row0, col0);
    }
};
struct EpiRes {
    static constexpr bool PERM = true, AFTER_DRAIN = false;
    bf16_t* HB; float* rowss_next;
    __device__ __forceinline__ void operator()(const f32x4 (&acc)[2][2][4][2], const pg8::Unit& u, int wr, int wc, int fr, int fq) const {
        const int row0 = u.pm * 256 + wr * 64 + fr, col0 = u.pn * 256 + wc * 32 + 8 * fq;
#pragma unroll
        for (int ai = 0; ai < 2; ++ai)
#pragma unroll
            for (int m = 0; m < 4; ++m) {
                const int row = row0 + ai * 128 + m * 16;
                float ss = 0.f;
                {
                    bf16_t* bp = HB + (size_t)row * DM + col0;
                    const u32x4 o0 = *(const u32x4*)bp, o1 = *(const u32x4*)(bp + 128);
#pragma unroll
                    for (int bj = 0; bj < 2; ++bj) {
                        const u32x4 o = bj ? o1 : o0;
                        const f32x4 a0 = acc[ai][bj][m][0], a1 = acc[ai][bj][m][1];
                        u32x4 w;
                        w.x = pk2(blo(o.x) + a0[0], bhi(o.x) + a0[1]); w.y = pk2(blo(o.y) + a0[2], bhi(o.y) + a0[3]);
                        w.z = pk2(blo(o.z) + a1[0], bhi(o.z) + a1[1]); w.w = pk2(blo(o.w) + a1[2], bhi(o.w) + a1[3]);
                        __builtin_nontemporal_store(w, (u32x4*)(bp + bj * 128));
                        const float h0 = blo(w.x), h1 = bhi(w.x), h2 = blo(w.y), h3 = bhi(w.y), h4 = blo(w.z), h5 = bhi(w.z), h6 = blo(w.w), h7 = bhi(w.w);
                        ss += ((h0 * h0 + h1 * h1) + (h2 * h2 + h3 * h3)) + ((h4 * h4 + h5 * h5) + (h6 * h6 + h7 * h7));
                    }
                }
                ss += __shfl_xor(ss, 16); ss += __shfl_xor(ss, 32);
                if (fq == 0) atomicAdd(rowss_next + row, ss);
            }
    }
};

struct EpiDummy {
    static constexpr bool PERM = true, AFTER_DRAIN = false;
    float* sink;
    __device__ __forceinline__ void operator()(const f32x4 (&acc)[2][2][4][2], const pg8::Unit& u, int wr, int wc, int fr, int fq) const {
        if (sink) { f32x4 t = {0.f, 0.f, 0.f, 0.f};
#pragma unroll
            for (int a = 0; a < 2; ++a)
#pragma unroll
                for (int b = 0; b < 2; ++b)
#pragma unroll
                    for (int m = 0; m < 4; ++m) { t += acc[a][b][m][0]; t += acc[a][b][m][1]; }
            *(f32x4*)(sink + (size_t)(u.pm * 4 + u.pn) * 2048 + (wr * 4 + wc) * 256 + (fr * 4 + fq) * 4) = t; }
    }
};
template <class Epi>
__device__ __forceinline__ void meta_gemm(const bf16_t* __restrict__ A, int lda, const bf16_t* __restrict__ Bt, int K, int N, const Epi& E, unsigned char* lds) {
    const int tid = otid(), wid = tid >> 6, lane = tid & 63, l16 = lane & 15, q = lane >> 4;
    float* red = (float*)lds;
    const int ks = K >> 3;
    for (int g = blockIdx.x; g < (N >> 4); g += gridDim.x) {
        const bf16_t* bp = Bt + (size_t)(16 * g + l16) * K + wid * ks + 8 * q;
        const bf16_t* ap = A + (size_t)l16 * lda + wid * ks + 8 * q;
        f32x4 acc[8];
#pragma unroll
        for (int rb = 0; rb < 8; ++rb) acc[rb] = (f32x4){0.f, 0.f, 0.f, 0.f};
#pragma unroll 4
        for (int k = 0; k < ks; k += 32) {
            const f16x8 bf = __builtin_bit_cast(f16x8, *(const bf16x8*)(bp + k));
#pragma unroll
            for (int rb = 0; rb < 8; ++rb)
                acc[rb] = __builtin_amdgcn_mfma_f32_16x16x32_f16(__builtin_bit_cast(f16x8, *(const bf16x8*)(ap + (size_t)(16 * rb) * lda + k)), bf, acc[rb], 0, 0, 0);
        }
#pragma unroll
        for (int rb = 0; rb < 8; ++rb) *(f32x4*)(red + ((wid * 8 + rb) * 64 + lane) * 4) = acc[rb];
        __syncthreads();
        f32x4 sum = {0.f, 0.f, 0.f, 0.f};
#pragma unroll
        for (int w2 = 0; w2 < 8; ++w2) sum += *(const f32x4*)(red + ((w2 * 8 + wid) * 64 + lane) * 4);
        E(NREAL + 16 * wid + 4 * q, 16 * g + l16, sum);
        __syncthreads();
    }
}
struct MetaRes {
    bf16_t* HB; float* rowss_next;
    __device__ __forceinline__ void operator()(int row0, int col, const f32x4& acc) const {
#pragma unroll
        for (int i = 0; i < 4; ++i) {
            bf16_t* p = HB + (size_t)(row0 + i) * DM + col;
            const bf16_t hn = f2b(b2f(*p) + acc[i]); *p = hn;
            float ss = b2f(hn); ss *= ss;
            ss += __shfl_xor(ss, 1); ss += __shfl_xor(ss, 2); ss += __shfl_xor(ss, 4); ss += __shfl_xor(ss, 8);
            if ((threadIdx.x & 15) == 0) atomicAdd(rowss_next + row0 + i, ss);
        }
    }
};
struct MetaUp {
    bf16_t* O; const float* rowss;
    __device__ __forceinline__ void operator()(int row0, int col, const f32x4& acc) const {
#pragma unroll
        for (int i = 0; i < 4; ++i) { const float v = fmaxf(acc[i] * rstd_of(rowss[row0 + i]), 0.f); O[(size_t)(row0 + i) * DFF + col] = f2b(v * v); }
    }
};
struct MetaHgrn {
    bf16_t* O; const float* rowss; const float* lb;
    __device__ __forceinline__ void operator()(int row0, int col, const f32x4& acc) const {
        const int typ = col >> 10;
        const float l = (typ == 1 || typ == 2) ? lb[col - 1024] : 0.f;
#pragma unroll
        for (int i = 0; i < 4; ++i) {
            const float x = acc[i] * rstd_of(rowss[row0 + i]); float r;
            if (typ == 0 || typ == 4) r = x * __builtin_amdgcn_rcpf(1.0f + __expf(-x));
            else if (typ == 3) r = x;
            else r = (1.0f - l) * __builtin_amdgcn_rcpf(1.0f + __expf(x));
            O[(size_t)(row0 + i) * NC + col] = f2b(r);
        }
    }
};

__device__ __forceinline__ void gen_adft(const Params& P, int bx, int G) {
    const int tid = otid(); unsigned char* ws = P.ws;
    const long gtid = (long)bx * 512 + tid, gthreads = (long)G * 512;
    {
        bf16_t* A = (bf16_t*)(ws + WS_ADFT);
        const long nch = (long)MF * (KF / 8);
        for (long ci = gtid; ci < nch; ci += gthreads) {
            const int lp = (int)(ci / (KF / 8)); const int cj = (int)(ci - (long)lp * (KF / 8));
            const int j0 = cj * 8; const int part = j0 >= LK ? 1 : 0; const int l0 = j0 - part * LK;
            u32x4 w = {0u, 0u, 0u, 0u};
            if (lp < LT && l0 < LT) {
                int mm = (int)(((long)lp * l0) % LT);
                float v[8];
#pragma unroll
                for (int e = 0; e < 8; ++e) {
                    const float rev = (float)mm * (1.0f / (float)LT);
                    v[e] = part ? -__builtin_amdgcn_sinf(rev) : __builtin_amdgcn_cosf(rev);
                    mm += lp; if (mm >= LT) mm -= LT;
                }
                w.x = pk2(v[0], v[1]); w.y = pk2(v[2], v[3]); w.z = pk2(v[4], v[5]); w.w = pk2(v[6], v[7]);
            }
            __builtin_nontemporal_store(w, (u32x4*)(A + (size_t)lp * KF + j0));
        }
    }
}

__device__ __forceinline__ void weight_jobs(const Params& P, unsigned char* lds, int job_lo, int job_hi, int bx, int G) {
    const int tid = otid();
    unsigned char* ws = P.ws;
    float* tile = (float*)lds;
#pragma nounroll
    for (int job = job_lo; job < job_hi; ++job) {
        const float* src; int ld, coff, K, N; bf16_t* dst; const float* gain;
        switch (job) {
            case 0: src = P.ab_w_in; ld = 1536; coff = 256; K = 1024; N = 1280; dst = (bf16_t*)(ws + W_QKV); gain = P.mix_gain; break;
            case 1: src = P.ab_w_out; ld = 1024; coff = 0; K = 1024; N = 1024; dst = (bf16_t*)(ws + W_O0); gain = nullptr; break;
            case 2: src = P.mlp_w1; ld = 4096; coff = 0; K = 1024; N = 4096; dst = (bf16_t*)(ws + W_1_0); gain = P.mlp_gain; break;
            case 3: src = P.mlp_w1 + (size_t)1024 * 4096; ld = 4096; coff = 0; K = 1024; N = 4096; dst = (bf16_t*)(ws + W_1_0 + 8 * MiB); gain = P.mlp_gain + 1024; break;
            case 4: src = P.mlp_w2; ld = 1024; coff = 0; K = 4096; N = 1024; dst = (bf16_t*)(ws + W_2_0); gain = nullptr; break;
            case 5: src = P.mlp_w2 + (size_t)4096 * 1024; ld = 1024; coff = 0; K = 4096; N = 1024; dst = (bf16_t*)(ws + W_2_0 + 8 * MiB); gain = nullptr; break;
            case 6: src = P.c_w_in; ld = 5120; coff = 0; K = 1024; N = 5120; dst = (bf16_t*)(ws + W_C); gain = P.mix_gain + 1024; break;
            default: src = P.c_w_out; ld = 1024; coff = 0; K = 1024; N = 1024; dst = (bf16_t*)(ws + W_O0 + 2 * MiB); gain = nullptr; break;
        }
        const int nkt = K >> 6, nnt = N >> 6, ntile = nkt * nnt;
        const int kr = tid >> 3, c8 = (tid & 7) * 8;
        f32x4 ra, rb; float rgn = 1.f;
        if (bx < ntile) { const int kt = bx % nkt, nt = bx / nkt; const float* sp = src + (size_t)(kt * 64 + kr) * ld + coff + nt * 64 + c8; ra = *(const f32x4*)sp; rb = *(const f32x4*)(sp + 4); rgn = gain ? gain[kt * 64 + kr] : 1.0f; }
        for (int ti = bx; ti < ntile; ti += G) {
            const int kt = ti % nkt, nt = ti / nkt, k0 = kt * 64, n0 = nt * 64;
            { float* tp = tile + kr * 65 + c8;
              tp[0] = ra[0] * rgn; tp[1] = ra[1] * rgn; tp[2] = ra[2] * rgn; tp[3] = ra[3] * rgn; tp[4] = rb[0] * rgn; tp[5] = rb[1] * rgn; tp[6] = rb[2] * rgn; tp[7] = rb[3] * rgn; }
            __syncthreads();
            if (ti + G < ntile) {
                const int t2 = ti + G, kt2 = t2 % nkt, nt2 = t2 / nkt; const float* sp = src + (size_t)(kt2 * 64 + kr) * ld + coff + nt2 * 64 + c8;
                ra = *(const f32x4*)sp; rb = *(const f32x4*)(sp + 4); rgn = gain ? gain[kt2 * 64 + kr] : 1.0f; }
            { const int nr = tid >> 3, k8 = (tid & 7) * 8;
              const float* tp = tile + k8 * 65 + nr;
              u32x4 w; w.x = pk2(tp[0], tp[65]); w.y = pk2(tp[130], tp[195]); w.z = pk2(tp[260], tp[325]); w.w = pk2(tp[390], tp[455]);
              __builtin_nontemporal_store(w, (u32x4*)(dst + (size_t)(n0 + nr) * K + k0 + k8)); }
            __syncthreads();
        }
    }
}

__device__ __forceinline__ void p0_prologue(const Params& P, unsigned char* lds) {
    const int tid = otid(), lane = tid & 63, wid = tid >> 6;
    const int G = gridDim.x, bx = blockIdx.x;
    unsigned char* ws = P.ws;
    float* tile = (float*)lds;
    float* twc = (float*)(lds + 64 * 65 * 4);
    float* tws = twc + 64;
    if (tid < 64) { twc[tid] = __builtin_amdgcn_cosf((float)tid * (1.0f / 64.0f)); tws[tid] = __builtin_amdgcn_sinf((float)tid * (1.0f / 64.0f)); }
    __syncthreads();
    weight_jobs(P, lds, 0, 1, bx, G);
    {
        const float scale = 0.0019493177f;
        bf16_t* dst = (bf16_t*)(ws + W_UCS);
        for (int ti = bx; ti < 256; ti += G) {
            const int kt = ti & 63, g = ti >> 6, k0 = kt * 16;
            if (tid < 256) { const int kr = tid >> 4, c4 = (tid & 15) * 4;
              const f32x4 a = *(const f32x4*)(P.ab_w_in + (size_t)(k0 + kr) * 1536 + g * 64 + c4);
              const float gn = P.mix_gain[k0 + kr] * scale;
              float* tp = tile + kr * 65 + c4; tp[0] = a[0] * gn; tp[1] = a[1] * gn; tp[2] = a[2] * gn; tp[3] = a[3] * gn; }
            __syncthreads();
            { const int cp = tid >> 3, k2 = (tid & 7) * 2;
              float ac0 = 0.f, ac1 = 0.f, as0 = 0.f, as1 = 0.f;
              for (int c = 0; c < 64; ++c) {
                  const int mm = (c * cp) & 63; const float cw = twc[mm], sw = tws[mm];
                  const float v0 = tile[k2 * 65 + c], v1 = tile[(k2 + 1) * 65 + c];
                  ac0 += v0 * cw; ac1 += v1 * cw; as0 += v0 * sw; as1 += v1 * sw;
              }
              *(unsigned*)(dst + (size_t)(g * 64 + cp) * DM + k0 + k2) = pk2(ac0, ac1);
              *(unsigned*)(dst + (size_t)(256 + g * 64 + cp) * DM + k0 + k2) = pk2(as0, as1); }
            __syncthreads();
        }
    }
    {
        float* rowss = (float*)(ws + WS_ROWSS); bf16_t* HB = (bf16_t*)(ws + WS_HB); bf16_t* Y = (bf16_t*)(ws + WS_Y);
        const int nw = G * 8;
        for (int row0 = bx * 8 + wid; row0 < TP; row0 += 2 * nw) {
            f32x4 v[2][4];
#pragma unroll
            for (int r = 0; r < 2; ++r) { const int row = row0 + r * nw;
                if (row < T) { const float* src = (row < NREAL ? P.x + (size_t)row * DM : P.meta + (size_t)((row - NREAL) & 15) * DM) + lane * 16;
#pragma unroll
                    for (int i = 0; i < 4; ++i) v[r][i] = *(const f32x4*)(src + 4 * i); }
                else {
#pragma unroll
                    for (int i = 0; i < 4; ++i) v[r][i] = (f32x4){0.f, 0.f, 0.f, 0.f}; } }
#pragma unroll
            for (int r = 0; r < 2; ++r) { const int row = row0 + r * nw;
                if (row < TP) {
                    float ss = 0.f;
#pragma unroll
                    for (int i = 0; i < 4; ++i) ss += (v[r][i][0] * v[r][i][0] + v[r][i][1] * v[r][i][1]) + (v[r][i][2] * v[r][i][2] + v[r][i][3] * v[r][i][3]);
                    u32x4 w0, w1;
                    w0.x = pk2(v[r][0][0], v[r][0][1]); w0.y = pk2(v[r][0][2], v[r][0][3]); w0.z = pk2(v[r][1][0], v[r][1][1]); w0.w = pk2(v[r][1][2], v[r][1][3]);
                    w1.x = pk2(v[r][2][0], v[r][2][1]); w1.y = pk2(v[r][2][2], v[r][2][3]); w1.z = pk2(v[r][3][0], v[r][3][1]); w1.w = pk2(v[r][3][2], v[r][3][3]);
                    *(u32x4*)(HB + (size_t)row * DM + lane * 16) = w0; *(u32x4*)(HB + (size_t)row * DM + lane * 16 + 8) = w1;
                    if (row >= T) { const u32x4 z = {0u, 0u, 0u, 0u}; *(u32x4*)(Y + (size_t)row * DM + lane * 16) = z; *(u32x4*)(Y + (size_t)row * DM + lane * 16 + 8) = z; }
                    ss = wave_sum(ss);
                    if (lane == 0) rowss[row] = ss;
                    if (lane >= 1 && lane < 5) rowss[(size_t)lane * TP + row] = 0.f;
                }
            }
        }
    }
    const long gtid = (long)bx * 512 + tid, gthreads = (long)G * 512;
    if (gtid < 2048) {
        const int dir = (int)gtid >> 10, c = (int)gtid & 1023;
        const float l0 = P.c_lb[dir * 1024 + c], l1 = P.c_lb[2048 + dir * 1024 + c];
        ((float*)(ws + WS_LB))[gtid] = 1.0f / (1.0f + __expf(l0 - l1));
    }
    {
        bf16_t* U = (bf16_t*)(ws + WS_UCST);
        for (long i = gtid; i < 2048 * 12; i += gthreads) {
            const int row = (int)(i / 12), k = (int)(i % 12), seg = k / 6, e = k % 6;
            const u32x4 z = {0u, 0u, 0u, 0u};
            *(u32x4*)(U + (size_t)row * KF + seg * LK + LT + e * 8) = z;
        }
    }
}

__device__ __forceinline__ void qk_norm_rope(const Params& P, int dry = 0) {
    const int tid = otid(), lane = tid & 63, wid = tid >> 6;
    bf16_t* ZQ = (bf16_t*)(P.ws + WS_ZQ);
    const int head = lane >> 3, d0 = (lane & 7) * 8;
    const float* gain = head < 6 ? P.ab_q_gain : P.ab_k_gain;
    float inv[8], g1[8], g2[8];
#pragma unroll
    for (int e = 0; e < 8; ++e) { inv[e] = __builtin_amdgcn_exp2f(-(float)((d0 + e) & 31) * (13.287712379549449f / 32.0f)); g1[e] = gain[d0 + e]; g2[e] = gain[64 + d0 + e]; }
    const int nw = gridDim.x * 8, w0 = blockIdx.x * 8 + wid;
    for (int row = w0; row < T; row += 2 * nw) {
        const int rowb = row + nw; const bool hasb = rowb < T;
        bf16_t* za = ZQ + (size_t)row * NQKV + head * 128 + d0; bf16_t* zb = ZQ + (size_t)(hasb ? rowb : row) * NQKV + head * 128 + d0;
        const u32x4 a1 = *(const u32x4*)za, a2 = *(const u32x4*)(za + 64), b1 = *(const u32x4*)zb, b2 = *(const u32x4*)(zb + 64);
#pragma unroll
        for (int it = 0; it < 2; ++it) {
            const u32x4 w1 = it ? b1 : a1, w2 = it ? b2 : a2; const int r = it ? rowb : row; bf16_t* zp = it ? zb : za;
            float x1[8], x2[8];
            x1[0] = blo(w1.x); x1[1] = bhi(w1.x); x1[2] = blo(w1.y); x1[3] = bhi(w1.y); x1[4] = blo(w1.z); x1[5] = bhi(w1.z); x1[6] = blo(w1.w); x1[7] = bhi(w1.w);
            x2[0] = blo(w2.x); x2[1] = bhi(w2.x); x2[2] = blo(w2.y); x2[3] = bhi(w2.y); x2[4] = blo(w2.z); x2[5] = bhi(w2.z); x2[6] = blo(w2.w); x2[7] = bhi(w2.w);
            float ss = 0.f;
#pragma unroll
            for (int e = 0; e < 8; ++e) ss += x1[e] * x1[e] + x2[e] * x2[e];
            ss += __shfl_xor(ss, 1); ss += __shfl_xor(ss, 2); ss += __shfl_xor(ss, 4);
            const float rs = rsqrtf(ss * (1.0f / 128.0f) + EPS);
            float o1[8], o2[8];
            const bool real = r < NREAL; const int pos = r & 4095; const float pv = (float)((lane & 7) < 4 ? (pos >> 6) : (pos & 63));
#pragma unroll
            for (int e = 0; e < 8; ++e) {
                const float y1 = x1[e] * rs * g1[e], y2 = x2[e] * rs * g2[e];
                float c = 1.f, sn = 0.f;
                if (real) { float rev = pv * inv[e] * 0.15915494309189535f; rev -= floorf(rev); c = __builtin_amdgcn_cosf(rev); sn = __builtin_amdgcn_sinf(rev); }
                o1[e] = y1 * c - y2 * sn; o2[e] = y2 * c + y1 * sn;
            }
            if (!dry && (it == 0 || hasb)) {
                u32x4 v1, v2;
                v1.x = pk2(o1[0], o1[1]); v1.y = pk2(o1[2], o1[3]); v1.z = pk2(o1[4], o1[5]); v1.w = pk2(o1[6], o1[7]);
                v2.x = pk2(o2[0], o2[1]); v2.y = pk2(o2[2], o2[3]); v2.z = pk2(o2[4], o2[5]); v2.w = pk2(o2[6], o2[7]);
                *(u32x4*)zp = v1; *(u32x4*)(zp + 64) = v2;
            }
        }
    }
}

namespace att {
constexpr int QBLK = 32, KVBLK = 64, NW = 8;
constexpr float SCALE = 0.088388347648318440f;
constexpr float THR = 8.f;
constexpr size_t SHM_V = KVBLK * 128 * 2, SHM_K = KVBLK * 128 * 2, SHM_ATTN = 2 * SHM_V + 2 * SHM_K + NW * 64 * 4;
constexpr int NT = 66;
#define KSWZ(row, colB) ((row) * 256 + ((colB) ^ (((row) & 7) << 4)))
#define SBAR() __builtin_amdgcn_sched_barrier(0)
__device__ __forceinline__ void partialSM(f32x16& p0, f32x16& p1, float& m_reg, float& mn, float& alpha) {
  constexpr float C = SCALE * 1.4426950408889634f;
  float pmax = p0[0]; for (int r = 1; r < 16; ++r) pmax = fmaxf(pmax, p0[r]); for (int r = 0; r < 16; ++r) pmax = fmaxf(pmax, p1[r]);
  { auto rr = __builtin_amdgcn_permlane32_swap(__float_as_uint(pmax), __float_as_uint(pmax), false, false);
    pmax = fmaxf(__uint_as_float(rr[0]), __uint_as_float(rr[1])); }
  if (__builtin_expect(__all(pmax - m_reg <= THR / SCALE), 1)) { mn = m_reg; alpha = 1.f; }
  else { mn = fmaxf(m_reg, pmax); alpha = __builtin_amdgcn_exp2f((m_reg - mn) * C); m_reg = mn; }
  float mnC = -mn * C;
  for (int r = 0; r < 16; ++r) p0[r] = fmaf(p0[r], C, mnC); for (int r = 0; r < 16; ++r) p1[r] = fmaf(p1[r], C, mnC);
  for (int r = 0; r < 16; ++r) p0[r] = __builtin_amdgcn_exp2f(p0[r]);
}
__device__ __forceinline__ void finishSM(f32x16& p0, f32x16& p1, float alpha, float& l_reg, bf16x8& pa0, bf16x8& pa1, bf16x8& pa2, bf16x8& pa3) {
  for (int r = 0; r < 16; ++r) p1[r] = __builtin_amdgcn_exp2f(p1[r]);
  float ps = 0; for (int r = 0; r < 16; ++r) ps += p0[r]; for (int r = 0; r < 16; ++r) ps += p1[r];
  { auto rr = __builtin_amdgcn_permlane32_swap(__float_as_uint(ps), __float_as_uint(ps), false, false);
    ps = __uint_as_float(rr[0]) + __uint_as_float(rr[1]); }
  l_reg = l_reg * alpha + ps;
#define PK4(P, BASE, OUT) do { unsigned a0 = pk2(P[BASE + 0], P[BASE + 1]), a1 = pk2(P[BASE + 2], P[BASE + 3]);   \
    unsigned b0 = pk2(P[BASE + 4], P[BASE + 5]), b1 = pk2(P[BASE + 6], P[BASE + 7]);                              \
    auto r0 = __builtin_amdgcn_permlane32_swap(a0, b0, false, false); auto r1 = __builtin_amdgcn_permlane32_swap(a1, b1, false, false); \
    u32x4 w = {r0[0], r1[0], r0[1], r1[1]}; OUT = *reinterpret_cast<bf16x8*>(&w); } while (0)
  PK4(p0, 0, pa0); PK4(p0, 8, pa1); PK4(p1, 0, pa2); PK4(p1, 8, pa3);
#undef PK4
}
__device__ __forceinline__ void qkt(f32x16& p0, f32x16& p1, const bf16_t* Ks, const bf16x8* qr, int r32, int hi) {
  p0 = f32x16{}; p1 = f32x16{};
  for (int d0 = 0; d0 < 8; ++d0) { int cb = (d0 * 16 + hi * 8) * 2;
    bf16x8 b0 = *reinterpret_cast<const bf16x8*>((const char*)Ks + KSWZ(r32, cb));
    bf16x8 b1 = *reinterpret_cast<const bf16x8*>((const char*)Ks + KSWZ(32 + r32, cb));
    p0 = mfma32(b0, qr[d0], p0);
    p1 = mfma32(b1, qr[d0], p1); }
}
__device__ __forceinline__ void kmask(f32x16& p0, f32x16& p1, int tile, int hi) {
  if (tile >= 64) {
    const int lim = tile == 64 ? 16 : 0;
#pragma unroll
    for (int r = 0; r < 16; ++r) { if (crow(r, hi) >= lim) p0[r] = -1e30f; p1[r] = -1e30f; }
  }
}
__device__ __forceinline__ int v_st(int k, int c) { const int kk = (k & ~0xC) | ((k & 4) << 1) | ((k & 8) >> 1); return ((kk >> 3) * 4 + (c >> 5)) * 512 + ((kk & 7) * 32 + (c & 31)) * 2; }
__device__ __forceinline__ int v_rd_base(int lane) { return ((lane & 3) << 3) | (((lane >> 2) & 3) << 6) | (((lane >> 4) & 1) << 5) | (((lane >> 5) & 1) << 8); }
constexpr int v_rd_off(int d0, int ks, int half) { return d0 * 512 + ks * 4096 + half * 2048; }
template <int OFF> __device__ __forceinline__ s16x4 tr_read(int vb) {
  s16x4 r; asm volatile("ds_read_b64_tr_b16 %0, %1 offset:%2" : "=&v"(r) : "v"(vb), "i"(OFF) : "memory"); return r;
}
template <int D0> __device__ __forceinline__ void pv_one(f32x16& od, int vb, bf16x8 pa0, bf16x8 pa1, bf16x8 pa2, bf16x8 pa3) {
  const s16x4 l0 = tr_read<v_rd_off(D0, 0, 0)>(vb), h0 = tr_read<v_rd_off(D0, 0, 1)>(vb), l1 = tr_read<v_rd_off(D0, 1, 0)>(vb), h1 = tr_read<v_rd_off(D0, 1, 1)>(vb);
  const s16x4 l2 = tr_read<v_rd_off(D0, 2, 0)>(vb), h2 = tr_read<v_rd_off(D0, 2, 1)>(vb), l3 = tr_read<v_rd_off(D0, 3, 0)>(vb), h3 = tr_read<v_rd_off(D0, 3, 1)>(vb);
  asm volatile("s_waitcnt lgkmcnt(0)" ::: "memory"); SBAR();
#define PK(L, H) (bf16x8){L[0], L[1], L[2], L[3], H[0], H[1], H[2], H[3]}
  od = mfma32(pa0, PK(l0, h0), od);
  od = mfma32(pa1, PK(l1, h1), od);
  od = mfma32(pa2, PK(l2, h2), od);
  od = mfma32(pa3, PK(l3, h3), od);
#undef PK
}
__device__ __forceinline__ void pv_d0(f32x16* o, int vb, bf16x8 pa0, bf16x8 pa1, bf16x8 pa2, bf16x8 pa3) {
  pv_one<0>(o[0], vb, pa0, pa1, pa2, pa3); pv_one<1>(o[1], vb, pa0, pa1, pa2, pa3); pv_one<2>(o[2], vb, pa0, pa1, pa2, pa3); pv_one<3>(o[3], vb, pa0, pa1, pa2, pa3);
}
__device__ __forceinline__ void attn_unit(const bf16_t* __restrict__ ZQ, bf16_t* __restrict__ Y, int b, int hsel, int qb, char* lds) {
  const int tid = otid(), wid = tid >> 6, lane = tid & 63, r32 = lane & 31, hi = lane >> 5;
  bf16_t* V_lds = (bf16_t*)lds; bf16_t* K_lds = (bf16_t*)(lds + 2 * SHM_V);
  float* ws = (float*)(lds + 2 * SHM_V + 2 * SHM_K) + wid * 64; float* li_l = ws; float* al_l = ws + 32;
  float m_reg = -1e30f, l_reg = 0; f32x16 o[4] = {}; bf16x8 qr[8];
  const bool meta = qb >= 16;
  const int h = meta ? hsel * 3 + (wid < 3 ? wid : 2) : hsel; const int kvh = meta ? hsel : hsel / 3;
  const long tb_real = (long)b * SEQ, tb_meta = (long)NREAL + 16 * b;
  { const long qrow = meta ? tb_meta + (r32 & 15) : tb_real + qb * 256 + wid * QBLK + r32;
    const bf16_t* Qw = ZQ + qrow * NQKV + h * 128 + hi * 8;
#pragma unroll
    for (int d0 = 0; d0 < 8; ++d0) qr[d0] = *reinterpret_cast<const bf16x8*>(Qw + d0 * 16); }
  const bf16_t* Kh = ZQ + 768 + kvh * 128; const bf16_t* Vh = ZQ + 1024 + kvh * 128;
  constexpr int LDK = NQKV;
  const int sr = tid >> 4, sc = (tid & 15) * 8, vst0 = v_st(sr, sc), vst1 = v_st(32 + sr, sc);
  const int vb0 = (int)(uintptr_t)V_lds + v_rd_base(lane);
  struct { bf16x8 vs0, vs1, ks0, ks1; } sr_[1];
#define SLOAD(i, t) do { const long k0_ = ((t) < 64 ? tb_real + 64 * (t) : tb_meta); sr_[i].vs0 = *reinterpret_cast<const bf16x8*>(&Vh[(k0_ + sr) * LDK + sc]); sr_[i].vs1 = *reinterpret_cast<const bf16x8*>(&Vh[(k0_ + 32 + sr) * LDK + sc]); \
    sr_[i].ks0 = *reinterpret_cast<const bf16x8*>(&Kh[(k0_ + sr) * LDK + sc]); sr_[i].ks1 = *reinterpret_cast<const bf16x8*>(&Kh[(k0_ + 32 + sr) * LDK + sc]); } while (0)
#define SWRITE(bb, i) do { *(bf16x8*)((char*)V_lds + (bb) * SHM_V + vst0) = sr_[i].vs0;          \
    *(bf16x8*)((char*)V_lds + (bb) * SHM_V + vst1) = sr_[i].vs1; int kc = sc * 2;               \
    *(bf16x8*)((char*)K_lds + (bb) * SHM_K + KSWZ(sr, kc)) = sr_[i].ks0;                       \
    *(bf16x8*)((char*)K_lds + (bb) * SHM_K + KSWZ(32 + sr, kc)) = sr_[i].ks1; } while (0)
#define SWAIT() asm volatile("s_waitcnt vmcnt(0)" ::: "memory")
#define RESC(a) do { if (__any((a) < 1.f)) { if (hi == 0) al_l[r32] = (a); asm volatile("s_waitcnt lgkmcnt(0)" ::: "memory"); \
    for (int d = 0; d < 4; ++d) for (int r = 0; r < 16; ++r) o[d][r] *= al_l[crow(r, hi)]; } } while (0)
  f32x16 pA0, pA1, pB0, pB1; float mnA, mnB, alA, alB; bf16x8 pa0, pa1, pa2, pa3;
  constexpr int SE = 0, SO = 0;
  SLOAD(SE, 0); asm volatile("s_waitcnt vmcnt(0)" ::: "memory"); SWRITE(0, SE); __syncthreads();
  qkt(pA0, pA1, K_lds, qr, r32, hi); partialSM(pA0, pA1, m_reg, mnA, alA);
  SLOAD(SO, 1);
  SWAIT(); SWRITE(1, SO); __syncthreads();
  for (int j = 1; j + 1 < NT; j += 2) {
    SBAR(); qkt(pB0, pB1, (bf16_t*)((char*)K_lds + SHM_K), qr, r32, hi); kmask(pB0, pB1, j, hi);
    finishSM(pA0, pA1, alA, l_reg, pa0, pa1, pa2, pa3); SBAR();
    SLOAD(SO, j + 1); SBAR();
    pv_d0(o, vb0, pa0, pa1, pa2, pa3); partialSM(pB0, pB1, m_reg, mnB, alB);
    __syncthreads(); SWAIT(); SWRITE(0, SE);
    RESC(alB); __syncthreads();
    SBAR(); qkt(pA0, pA1, K_lds, qr, r32, hi); kmask(pA0, pA1, j + 1, hi);
    finishSM(pB0, pB1, alB, l_reg, pa0, pa1, pa2, pa3); SBAR();
    SLOAD(SE, j + 2); SBAR();
    pv_d0(o, vb0 + (int)SHM_V, pa0, pa1, pa2, pa3); partialSM(pA0, pA1, m_reg, mnA, alA);
    __syncthreads(); SWAIT(); SWRITE(1, SO);
    RESC(alA); __syncthreads();
  }
  SBAR(); finishSM(pA0, pA1, alA, l_reg, pa0, pa1, pa2, pa3); SBAR();
  pv_d0(o, vb0, pa0, pa1, pa2, pa3);
  if (hi == 0) li_l[r32] = l_reg; asm volatile("s_waitcnt lgkmcnt(0)" ::: "memory");
  float rli[16];
#pragma unroll
  for (int r = 0; r < 16; ++r) rli[r] = __builtin_amdgcn_rcpf(li_l[crow(r, hi)]);
#pragma unroll
  for (int r = 0; r < 16; ++r) { const int ri = crow(r, hi);
    if (!meta || (wid < 3 && ri < 16)) { bf16_t* yp = Y + (meta ? tb_meta + ri : tb_real + qb * 256 + wid * QBLK + ri) * DM + 256 + h * 128 + r32;
#pragma unroll
      for (int d0 = 0; d0 < 4; ++d0) yp[d0 * 32] = f2b(o[d0][r] * rli[r]); } }
  __syncthreads();
#undef SLOAD
#undef SWRITE
#undef SWAIT
#undef RESC
}
}

#define LBAR() asm volatile("s_waitcnt lgkmcnt(0)\n\ts_barrier" ::: "memory")
__device__ __forceinline__ void scan_unit(const bf16_t* __restrict__ Z1, bf16_t* __restrict__ OUT, int b, int h, int dir, int vs, unsigned char* lds, int dry = 0) {
    const int tid = otid(), wid = tid >> 6, lane = tid & 63, r32 = lane & 31, hi = lane >> 5;
    float* TOT = (float*)(lds); float* DVv = (float*)(lds + 4096);
    bf16_t* QT = (bf16_t*)(lds + 4608); bf16_t* KT = (bf16_t*)(lds + 22016); bf16_t* QI = (bf16_t*)(lds + 39424); bf16_t* KHT = (bf16_t*)(lds + 56832);
    bf16_t* VT = (bf16_t*)(lds + 75264); bf16_t* AS = (bf16_t*)(lds + 84480); bf16_t* SB = (bf16_t*)(lds + 93696);
    const int cp = tid & 63, seg = __builtin_amdgcn_readfirstlane(tid >> 6);
    const int vp = tid & 31, tgv = tid >> 5;
    const bf16_t* Qg = Z1 + h * 128 + 2 * cp; const bf16_t* Gg = Z1 + 1024 + dir * 1024 + h * 128 + 2 * cp; const bf16_t* Vg = Z1 + 3072 + h * 128 + vs * 64 + 2 * vp;
    f32x16 Sacc = {}; f32x16 oacc = {};
    for (int i = tid; i < 17408 / 4; i += 512) ((unsigned*)SB)[i] = 0u;
    int cur = 0;
    unsigned rq[8], rk[8], rv[4];
#define LOADC(cc) do { const int c_ = (cc); const long tk_ = c_ ? (long)b * SEQ + 64 * (c_ - 1) : (long)NREAL + 16 * b; \
    if (c_ != 0 || seg < 2) { const bf16_t* qp_ = Qg + (size_t)(tk_ + 8 * seg) * NC; const bf16_t* gp_ = Gg + (size_t)(tk_ + 8 * seg) * NC; \
        _Pragma("unroll") for (int i_ = 0; i_ < 8; ++i_) { rq[i_] = *(const unsigned*)qp_; rk[i_] = *(const unsigned*)gp_; qp_ += NC; gp_ += NC; } } \
    else { _Pragma("unroll") for (int i_ = 0; i_ < 8; ++i_) { rq[i_] = 0u; rk[i_] = 0u; } } \
    if (c_ != 0 || tgv < 4) { const bf16_t* vp_ = Vg + (size_t)(tk_ + 4 * tgv) * NC; \
        _Pragma("unroll") for (int i_ = 0; i_ < 4; ++i_) { rv[i_] = *(const unsigned*)vp_; vp_ += NC; } } \
    else { _Pragma("unroll") for (int i_ = 0; i_ < 4; ++i_) rv[i_] = 0u; } } while (0)
    LOADC(dir ? 64 : 0);
#pragma nounroll
    for (int step = 0; step < 65; ++step) {
        const int c = dir ? 64 - step : step;
        const long tok0 = c ? (long)b * SEQ + 64 * (c - 1) : (long)NREAL + 16 * b; const int nvalid = c ? 64 : 16;
        float ka[8], kb[8], pa[8], pb[8];
#pragma unroll
        for (int i = 0; i < 8; ++i) { ka[i] = blo(rk[i]); kb[i] = bhi(rk[i]); }
        { float xa = 1.f, xb = 1.f;
          if (dir == 0) {
#pragma unroll
              for (int i = 0; i < 8; ++i) { xa *= 1.0f - ka[i]; xb *= 1.0f - kb[i]; pa[i] = xa; pb[i] = xb; } }
          else {
#pragma unroll
              for (int i = 7; i >= 0; --i) { xa *= 1.0f - ka[i]; xb *= 1.0f - kb[i]; pa[i] = xa; pb[i] = xb; } }
          *(f32x2*)(TOT + seg * 128 + 2 * cp) = (f32x2){xa, xb}; }
        LBAR();
        {
            f32x2 Ts[8];
#pragma unroll
            for (int s_ = 0; s_ < 8; ++s_) Ts[s_] = *(const f32x2*)(TOT + s_ * 128 + 2 * cp);
            const f32x2 lo4 = (Ts[0] * Ts[1]) * (Ts[2] * Ts[3]), hi4 = (Ts[4] * Ts[5]) * (Ts[6] * Ts[7]);
            const f32x2 one = {1.f, 1.f};
            f32x2 cs, eref, erest;
            if (dir == 0) {
                eref = lo4; erest = hi4;
                if (seg <= 3) { f32x2 m = one;
#pragma unroll
                    for (int s_ = 0; s_ < 4; ++s_) m = m * (s_ >= seg ? Ts[s_] : one);
                    cs.x = __builtin_amdgcn_rcpf(m.x); cs.y = __builtin_amdgcn_rcpf(m.y); }
                else { f32x2 m = one;
#pragma unroll
                    for (int s_ = 4; s_ < 7; ++s_) m = m * (s_ < seg ? Ts[s_] : one);
                    cs = m; }
            } else {
                eref = hi4; erest = lo4;
                if (seg >= 4) { f32x2 m = one;
#pragma unroll
                    for (int s_ = 4; s_ < 8; ++s_) m = m * (s_ <= seg ? Ts[s_] : one);
                    cs.x = __builtin_amdgcn_rcpf(m.x); cs.y = __builtin_amdgcn_rcpf(m.y); }
                else { f32x2 m = one;
#pragma unroll
                    for (int s_ = 1; s_ < 4; ++s_) m = m * (s_ > seg ? Ts[s_] : one);
                    cs = m; }
            }
            float kha[8], khb[8];
#pragma unroll
            for (int i = 0; i < 8; ++i) {
                const float Ra = pa[i] * cs.x, Rb = pb[i] * cs.y;
                const float qa = blo(rq[i]), qb_ = bhi(rq[i]);
                const float ia = __builtin_amdgcn_rcpf(Ra), ib = __builtin_amdgcn_rcpf(Rb);
                const float qra = qa * Ra, qrb = qb_ * Rb, kia = ka[i] * ia, kib = kb[i] * ib;
                const int o_ = (8 * seg + i) * 136 + 2 * cp;
                *(unsigned*)(QT + o_) = pk2_bf(qra, qrb);
                *(unsigned*)(QI + o_) = pk2(qra * eref.x, qrb * eref.y);
                *(unsigned*)(KT + o_) = pk2_bf(kia, kib);
                kha[i] = kia * erest.x; khb[i] = kib * erest.y;
            }
            u32x4 w0, w1;
            w0.x = pk2(kha[0], kha[1]); w0.y = pk2(kha[2], kha[3]); w0.z = pk2(kha[4], kha[5]); w0.w = pk2(kha[6], kha[7]);
            w1.x = pk2(khb[0], khb[1]); w1.y = pk2(khb[2], khb[3]); w1.z = pk2(khb[4], khb[5]); w1.w = pk2(khb[6], khb[7]);
            *(u32x4*)(KHT + (2 * cp) * 72 + 8 * seg) = w0; *(u32x4*)(KHT + (2 * cp + 1) * 72 + 8 * seg) = w1;
            if (seg == 0) *(f32x2*)(DVv + 2 * cp) = lo4 * hi4;
            u32x2 va, vb;
            va.x = (rv[0] & 0xffffu) | (rv[1] << 16); va.y = (rv[2] & 0xffffu) | (rv[3] << 16);
            vb.x = (rv[0] >> 16) | (rv[1] & 0xffff0000u); vb.y = (rv[2] >> 16) | (rv[3] & 0xffff0000u);
            *(u32x2*)(VT + (2 * vp) * 72 + 4 * tgv) = va; *(u32x2*)(VT + (2 * vp + 1) * 72 + 4 * tgv) = vb;
        }
        if (step + 1 < 65 && !(dry & 2)) LOADC(dir ? 63 - step : step + 1);
        LBAR();
        if (wid < 4) {
            const int a = wid >> 1, sb = wid & 1;
            f32x16 p = {};
            const bf16_t* kp = KT + (32 * sb + r32) * 136 + 8 * hi; const bf16_t* qp = QT + (32 * a + r32) * 136 + 8 * hi;
#pragma unroll
            for (int kk = 0; kk < 8; ++kk) p = __builtin_amdgcn_mfma_f32_32x32x16_bf16(*(const bf16x8*)(kp + 16 * kk), *(const bf16x8*)(qp + 16 * kk), p, 0, 0, 0);
            const int t = 32 * a + r32;
#pragma unroll
            for (int r4 = 0; r4 < 4; ++r4) {
                const int s0 = 32 * sb + 8 * r4 + 4 * hi; float v[4];
#pragma unroll
                for (int e = 0; e < 4; ++e) { const int s_ = s0 + e; const bool keep = dir == 0 ? (s_ <= t) : (s_ >= t); v[e] = keep ? p[4 * r4 + e] : 0.f; }
                u32x2 w; w.x = pk2(v[0], v[1]); w.y = pk2(v[2], v[3]);
                *(u32x2*)(AS + t * 72 + s0) = w;
            }
        } else {
            const int a = (wid - 4) >> 1, j = (wid - 4) & 1;
            oacc = f32x16{};
            const bf16_t* qp = QI + (32 * a + r32) * 136 + 8 * hi; const bf16_t* sp = SB + cur * 8704 + (32 * j + r32) * 136 + 8 * hi;
#pragma unroll
            for (int kk = 0; kk < 8; ++kk) oacc = mfma32(*(const bf16x8*)(qp + 16 * kk), *(const bf16x8*)(sp + 16 * kk), oacc);
        }
        {
            const int i = wid >> 1, j = wid & 1;
#pragma unroll
            for (int r = 0; r < 16; ++r) Sacc[r] *= DVv[32 * i + crow(r, hi)];
            const bf16_t* ap = KHT + (32 * i + r32) * 72 + 8 * hi; const bf16_t* vp = VT + (32 * j + r32) * 72 + 8 * hi;
#pragma unroll
            for (int kk = 0; kk < 4; ++kk) Sacc = mfma32(*(const bf16x8*)(ap + 16 * kk), *(const bf16x8*)(vp + 16 * kk), Sacc);
            bf16_t* sbn = SB + (cur ^ 1) * 8704 + (32 * j + r32) * 136 + 32 * i + 4 * hi;
#pragma unroll
            for (int r4 = 0; r4 < 4; ++r4) { u32x2 w; w.x = pk2(Sacc[4 * r4], Sacc[4 * r4 + 1]); w.y = pk2(Sacc[4 * r4 + 2], Sacc[4 * r4 + 3]); *(u32x2*)(sbn + 8 * r4) = w; }
        }
        LBAR();
        if (wid >= 4) {
            const int a = (wid - 4) >> 1, j = (wid - 4) & 1;
            const bf16_t* ap = AS + (32 * a + r32) * 72 + 8 * hi; const bf16_t* vp = VT + (32 * j + r32) * 72 + 8 * hi;
#pragma unroll
            for (int kk = 0; kk < 4; ++kk) oacc = mfma32(*(const bf16x8*)(ap + 16 * kk), *(const bf16x8*)(vp + 16 * kk), oacc);
            bf16_t* ost = QT + (wid - 4) * 1280;
#pragma unroll
            for (int r = 0; r < 16; ++r) ost[crow(r, hi) * 40 + r32] = f2b(oacc[r]);
            asm volatile("s_waitcnt lgkmcnt(0)" ::: "memory");
#pragma unroll
            for (int i = 0; i < 2; ++i) {
                const int pc = lane + 64 * i, row = pc >> 2, sg = pc & 3;
                const u32x4 w = *(const u32x4*)(ost + row * 40 + sg * 8);
                if (32 * a + row < nvalid && !(dry & 1)) *(u32x4*)(OUT + (size_t)(tok0 + 32 * a + row) * DM + h * 128 + vs * 64 + 32 * j + sg * 8) = w;
            }
        }
        cur ^= 1;
    }
    __syncthreads();
#undef LOADC
}

__device__ __forceinline__ void hgrn_finalize(const Params& P, int dry = 0) {
    const int tid = otid(), lane = tid & 63, wid = tid >> 6;
    const bf16_t* O = (const bf16_t*)P.out; const bf16_t* Z1 = (const bf16_t*)(P.ws + WS_Z1); bf16_t* Y = (bf16_t*)(P.ws + WS_Y);
    const int col = (lane >> 3) * 128 + (lane & 7) * 16;
    float og[16];
#pragma unroll
    for (int e = 0; e < 16; ++e) og[e] = P.c_o_gain[col + e];
    const int nw = gridDim.x * 8, w0 = blockIdx.x * 8 + wid;
    for (int row = w0; row < T; row += 2 * nw) {
        const int rowb = row + nw; const bool hasb = rowb < T; const int rb = hasb ? rowb : row;
        u32x4 oa[2], ya[2], ga[2], ob[2], yb[2], gb[2];
#pragma unroll
        for (int i = 0; i < 2; ++i) {
            oa[i] = *(const u32x4*)(O + (size_t)row * DM + col + 8 * i); ya[i] = *(const u32x4*)(Y + (size_t)row * DM + col + 8 * i); ga[i] = *(const u32x4*)(Z1 + (size_t)row * NC + 4096 + col + 8 * i);
            ob[i] = *(const u32x4*)(O + (size_t)rb * DM + col + 8 * i); yb[i] = *(const u32x4*)(Y + (size_t)rb * DM + col + 8 * i); gb[i] = *(const u32x4*)(Z1 + (size_t)rb * NC + 4096 + col + 8 * i);
        }
#pragma unroll
        for (int it = 0; it < 2; ++it) {
            float o[16], g[16];
#pragma unroll
            for (int i = 0; i < 2; ++i) {
                const u32x4 ow = it ? ob[i] : oa[i], yw = it ? yb[i] : ya[i], gw = it ? gb[i] : ga[i];
                o[8 * i + 0] = blo(ow.x) + blo(yw.x); o[8 * i + 1] = bhi(ow.x) + bhi(yw.x); o[8 * i + 2] = blo(ow.y) + blo(yw.y); o[8 * i + 3] = bhi(ow.y) + bhi(yw.y);
                o[8 * i + 4] = blo(ow.z) + blo(yw.z); o[8 * i + 5] = bhi(ow.z) + bhi(yw.z); o[8 * i + 6] = blo(ow.w) + blo(yw.w); o[8 * i + 7] = bhi(ow.w) + bhi(yw.w);
                g[8 * i + 0] = blo(gw.x); g[8 * i + 1] = bhi(gw.x); g[8 * i + 2] = blo(gw.y); g[8 * i + 3] = bhi(gw.y); g[8 * i + 4] = blo(gw.z); g[8 * i + 5] = bhi(gw.z); g[8 * i + 6] = blo(gw.w); g[8 * i + 7] = bhi(gw.w);
            }
            float ss = 0.f;
#pragma unroll
            for (int e = 0; e < 16; ++e) ss += o[e] * o[e];
            ss += __shfl_xor(ss, 1); ss += __shfl_xor(ss, 2); ss += __shfl_xor(ss, 4);
            const float rs = rsqrtf(ss * (1.0f / 128.0f) + EPS);
            if (!dry && (it == 0 || hasb)) {
                bf16_t* yp = Y + (size_t)(it ? rb : row) * DM + col;
#pragma unroll
                for (int i = 0; i < 2; ++i) {
                    u32x4 w;
                    w.x = pk2(o[8 * i + 0] * rs * og[8 * i + 0] * g[8 * i + 0], o[8 * i + 1] * rs * og[8 * i + 1] * g[8 * i + 1]);
                    w.y = pk2(o[8 * i + 2] * rs * og[8 * i + 2] * g[8 * i + 2], o[8 * i + 3] * rs * og[8 * i + 3] * g[8 * i + 3]);
                    w.z = pk2(o[8 * i + 4] * rs * og[8 * i + 4] * g[8 * i + 4], o[8 * i + 5] * rs * og[8 * i + 5] * g[8 * i + 5]);
                    w.w = pk2(o[8 * i + 6] * rs * og[8 * i + 6] * g[8 * i + 6], o[8 * i + 7] * rs * og[8 * i + 7] * g[8 * i + 7]);
                    *(u32x4*)(yp + 8 * i) = w;
                }
            }
        }
    }
}

__device__ __forceinline__ void fast_barrier(unsigned* bar, unsigned gen) {
    asm volatile("s_waitcnt vmcnt(0) lgkmcnt(0)" ::: "memory");
    __syncthreads();
    if (threadIdx.x == 0) {
        const unsigned g = blockIdx.x >> 5, ng = (gridDim.x + 31) >> 5;
        const unsigned gsz = (g + 1) * 32 <= gridDim.x ? 32u : gridDim.x - g * 32;
        __builtin_amdgcn_fence(__ATOMIC_RELEASE, "agent");
        asm volatile("s_waitcnt vmcnt(0)" ::: "memory");
        if (__hip_atomic_fetch_add(bar + 64 * g, 1u, __ATOMIC_RELAXED, __HIP_MEMORY_SCOPE_AGENT) + 1u == gsz * gen) {
            if (__hip_atomic_fetch_add(bar + 512, 1u, __ATOMIC_RELAXED, __HIP_MEMORY_SCOPE_AGENT) + 1u == ng * gen) {
                for (unsigned i = 0; i < ng; ++i) __hip_atomic_store(bar + 1024 + 64 * i, gen, __ATOMIC_RELAXED, __HIP_MEMORY_SCOPE_AGENT);
            }
        }
        while (__hip_atomic_load(bar + 1024 + 64 * g, __ATOMIC_RELAXED, __HIP_MEMORY_SCOPE_AGENT) < gen) __builtin_amdgcn_s_sleep(1);
        __builtin_amdgcn_fence(__ATOMIC_ACQUIRE, "agent");
        asm volatile("s_waitcnt vmcnt(0)" ::: "memory");
    }
    __syncthreads();
}
#ifdef REP_SYNC
#define GSYNC() do { ++nbar; fast_barrier(barw, nbar); ++nbar; fast_barrier(barw, nbar); } while (0)
#else
#define GSYNC() do { ++nbar; fast_barrier(barw, nbar); } while (0)
#endif
__global__ void __launch_bounds__(512) fwd_megakernel(Params P) {
    extern __shared__ __attribute__((aligned(16))) unsigned char lds[];
    cg::grid_group grid = cg::this_grid();
    PG8_LAS unsigned char* lds3 = (PG8_LAS unsigned char*)lds;
    unsigned char* ws = P.ws;
    const int G = gridDim.x, bx = blockIdx.x;
    float* rowss = (float*)(ws + WS_ROWSS);
    bf16_t* HB = (bf16_t*)(ws + WS_HB); bf16_t* Y = (bf16_t*)(ws + WS_Y);
    unsigned* barw = (unsigned*)(ws + WS_BAR); unsigned nbar = 0;

#ifndef REP_P0
#define REP_P0 1
#endif
#ifndef REP_ATTN
#define REP_ATTN 1
#endif
#ifndef REP_SCAN
#define REP_SCAN 1
#endif
#ifndef REP_FOUR
#define REP_FOUR 1
#endif
#ifndef REP_UP
#define REP_UP 1
#endif
#ifndef REP_META
#define REP_META 1
#endif
#ifndef REP_IN
#define REP_IN 1
#endif
#ifndef REP_HG
#define REP_HG 1
#endif
#ifndef SCAN_DRY
#define SCAN_DRY 0
#endif
#pragma nounroll
    for (int rep = 0; rep < REP_P0; ++rep) { p0_prologue(P, lds); if (rep + 1 < REP_P0) GSYNC(); }
    asm volatile("s_waitcnt vmcnt(0)" ::: "memory"); grid.sync();

#pragma nounroll
    for (int layer = 0; layer < 2; ++layer) {
        if (layer == 0) {
            { pg8::Gemm g{(const bf16_t*)(ws + W_UCS), HB, 512, TP, DM}; pg8::StaticOrder S; S.init(512, TP, G, bx);
              EpiUcs E{(bf16_t*)(ws + WS_UCST), rowss};
#ifndef NO_G_UCS
              for (int rep = 0; rep < REP_IN; ++rep)
              pg8::gemm_phase<EpiUcs, pg8::StaticOrder, true, true>(lds3, g, S, E);
#endif
            }
            { pg8::Gemm g{HB, (const bf16_t*)(ws + W_QKV), TP, NQKV, DM}; pg8::StaticOrder S; S.init(TP, NQKV, G, G - 1 - bx);
              EpiAct<0> E{(bf16_t*)(ws + WS_ZQ), NQKV, rowss};
#ifndef NO_G_A0
              for (int rep = 0; rep < REP_IN; ++rep)
              pg8::gemm_phase<EpiAct<0>, pg8::StaticOrder, true, true>(lds3, g, S, E);
#endif
            }
            if (bx >= 2 && bx < 123) gen_adft(P, bx - 2, 121);
            GSYNC();
#ifdef REP_EW
            qk_norm_rope(P, (int)(P.c_lb != nullptr));
#endif
            qk_norm_rope(P);
            GSYNC();
#pragma nounroll
            for (int rep = 0; rep < REP_ATTN; ++rep)
            for (int u = bx; u < NB * 6 * 16 + 16; u += G) {
                int b, h, qb;
                if (u < NB * 96) { b = bx & 7; const int ul = (bx >> 3) + 32 * (u >> 8); h = ul >> 4; qb = ul & 15; } else { const int m = u - NB * 96; b = m & 7; h = m >> 3; qb = 16; }
#ifndef NO_ATTN
                att::attn_unit((const bf16_t*)(ws + WS_ZQ), Y, b, h, qb, (char*)lds);
#endif
            }
            if (bx >= 152) weight_jobs(P, lds, 1, 8, bx - 152, G - 152);
            { pg8::Gemm g{(const bf16_t*)(ws + WS_ADFT), (const bf16_t*)(ws + WS_UCST), MF, 2048, KF}; pg8::StaticOrder S; S.init(MF, 2048, 136, bx - 16);
              EpiFour E{Y};
#ifndef NO_G_FOUR
              if (bx >= 16 && bx < 152)
#pragma nounroll
              for (int rep = 0; rep < REP_FOUR; ++rep)
              pg8::gemm_phase<EpiFour, pg8::StaticOrder, true, true>(lds3, g, S, E);
#endif
            }
            GSYNC();
        } else {
            { pg8::Gemm g{HB, (const bf16_t*)(ws + W_C), NREAL, NC, DM}; pg8::StaticOrder S; S.init(NREAL, NC, G, bx);
              EpiHgrn E{(bf16_t*)(ws + WS_Z1), rowss + 2 * (size_t)TP, (const float*)(ws + WS_LB)};
#ifndef NO_G_HGRN
              for (int rep = 0; rep < REP_HG; ++rep)
              pg8::gemm_phase<EpiHgrn, pg8::StaticOrder, true, true>(lds3, g, S, E);
#endif
            }
            { MetaHgrn E{(bf16_t*)(ws + WS_Z1), rowss + 2 * (size_t)TP, (const float*)(ws + WS_LB)};
              for (int rep = 0; rep < REP_META; ++rep) meta_gemm(HB + (size_t)NREAL * DM, DM, (const bf16_t*)(ws + W_C), DM, NC, E, lds); }
            GSYNC();
#pragma nounroll
            for (int rep = 0; rep < REP_SCAN; ++rep)
            for (int u = bx; u < NB * 8 * 4; u += G) {
                const int slot = u >> 3, grp = (u & 7) * 8 + (slot >> 2); const int b = grp >> 3, h = grp & 7, vs = (slot >> 1) & 1, dir = slot & 1;
#ifndef NO_SCAN
                scan_unit((const bf16_t*)(ws + WS_Z1), dir ? Y : (bf16_t*)P.out, b, h, dir, vs, lds, rep + 1 < REP_SCAN ? SCAN_DRY : 0);
#endif
            }
            GSYNC();
#if defined(STOP_AT) && STOP_AT == 5
            { const int tid = otid(); for (long i = (long)bx * 512 + tid; i < (long)NB * SEQ * DM; i += (long)G * 512) P.out[i] = b2f(HB[i]); return; }
#endif
#ifdef REP_EW
            hgrn_finalize(P, (int)(P.c_lb != nullptr));
#endif
            hgrn_finalize(P);
            GSYNC();
#if defined(STOP_AT) && STOP_AT == 6
            { const int tid = otid(); for (long i = (long)bx * 512 + tid; i < (long)NB * SEQ * DM; i += (long)G * 512) P.out[i] = b2f(Y[i]); return; }
#endif
        }
#if defined(STOP_AT) && STOP_AT == 1
        if (layer == 0) return;
#endif
#if defined(STOP_AT) && STOP_AT == 4
        if (layer == 1) return;
#endif
        int bxl = bx, Gl = G; asm volatile("" : "+s"(bxl), "+s"(Gl));
        const int MG = NREAL;
        { pg8::Gemm g{Y, (const bf16_t*)(ws + W_O0 + (size_t)layer * 2 * MiB), MG, DM, DM}; pg8::StaticOrder S; S.init(MG, DM, Gl, bxl);
          EpiRes E{HB, rowss + (size_t)(1 + 2 * layer) * TP};
#ifndef NO_G_RES
          pg8::gemm_phase<EpiRes, pg8::StaticOrder, true, true>(lds3, g, S, E);
#endif
            }
        if (layer == 0) { MetaRes E{HB, rowss + (size_t)TP}; meta_gemm(Y + (size_t)NREAL * DM, DM, (const bf16_t*)(ws + W_O0), DM, DM, E, lds); }
        GSYNC();
#if defined(STOP_AT) && STOP_AT == 2
        if (layer == 0) return;
#endif
        { pg8::Gemm g{HB, (const bf16_t*)(ws + W_1_0 + (size_t)layer * 8 * MiB), MG, DFF, DM}; pg8::StaticOrder S; S.init(MG, DFF, Gl, bxl);
          EpiAct<1> E{(bf16_t*)(ws + WS_HID), DFF, rowss + (size_t)(1 + 2 * layer) * TP};
#ifndef NO_G_A1
#pragma nounroll
          for (int rep = 0; rep < REP_UP; ++rep)
          pg8::gemm_phase<EpiAct<1>, pg8::StaticOrder, true, true>(lds3, g, S, E);
#endif
            }
        if (layer == 0) { MetaUp E{(bf16_t*)(ws + WS_HID), rowss + (size_t)TP}; for (int rep = 0; rep < REP_META; ++rep) meta_gemm(HB + (size_t)NREAL * DM, DM, (const bf16_t*)(ws + W_1_0), DM, DFF, E, lds); }
        GSYNC();
        { pg8::Gemm g{(const bf16_t*)(ws + WS_HID), (const bf16_t*)(ws + W_2_0 + (size_t)layer * 8 * MiB), MG, DM, DFF}; pg8::StaticOrder S; S.init(MG, DM, Gl, bxl);
          EpiRes E{HB, rowss + (size_t)(2 + 2 * layer) * TP};
#ifdef REP_DOWN
          { EpiDummy ED{(float*)P.c_lb == nullptr ? (float*)(ws + WS_Y) : nullptr}; pg8::gemm_phase<EpiDummy, pg8::StaticOrder, true, true>(lds3, g, S, ED); }
#endif
#ifndef NO_G_RES
          pg8::gemm_phase<EpiRes, pg8::StaticOrder, true, true>(lds3, g, S, E);
#endif
            }
        if (layer == 0) { MetaRes E{HB, rowss + 2 * (size_t)TP}; meta_gemm((const bf16_t*)(ws + WS_HID) + (size_t)NREAL * DFF, DFF, (const bf16_t*)(ws + W_2_0), DFF, DM, E, lds); }
        GSYNC();
#if defined(STOP_AT) && STOP_AT == 3
        if (layer == 0) return;
#endif
    }
    const int tid = otid(), lane = tid & 63, wid = tid >> 6;
#ifdef REP_EW
    for (int rep = 0; rep < 2; ++rep)
#endif
    for (int orow = bx * 8 + wid; orow < NB * SEQ; orow += G * 8) {
        const float rs = rstd_of(rowss[(size_t)4 * TP + orow]);
        float* hp = P.out + (size_t)orow * DM; const bf16_t* hb = HB + (size_t)orow * DM;
#pragma unroll
        for (int i = 0; i < 4; ++i) {
            const int col = i * 256 + lane * 4;
            const u32x2 hw = *(const u32x2*)(hb + col); const f32x4 g = *(const f32x4*)(P.final_gain + col);
            const f32x4 v = {blo(hw.x), bhi(hw.x), blo(hw.y), bhi(hw.y)};
            *(f32x4*)(hp + col) = v * rs * g;
        }
    }
}

extern "C" void kernel_launch(void* const* d_in, const int* in_sizes, int n_in, void* d_out, int out_size, void* d_ws, size_t ws_size, hipStream_t stream) {
    static int grid_blocks = 0;
    if (grid_blocks == 0) {
        if (n_in != 15 || out_size != NB * SEQ * DM || ws_size < WS_NEED) { fprintf(stderr, "kernel_launch: unexpected shapes (n_in %d out %d ws %zu, need %zu)\n", n_in, out_size, ws_size, (size_t)WS_NEED); grid_blocks = -1; return; }
        int dev = 0, cus = 0, per_cu = 0;
        hipGetDevice(&dev);
        hipDeviceGetAttribute(&cus, hipDeviceAttributeMultiprocessorCount, dev);
        if (hipFuncSetAttribute((const void*)fwd_megakernel, hipFuncAttributeMaxDynamicSharedMemorySize, LDS_BYTES) != hipSuccess) { fprintf(stderr, "kernel_launch: hipFuncSetAttribute failed\n"); grid_blocks = -1; return; }
        if (hipOccupancyMaxActiveBlocksPerMultiprocessor(&per_cu, (const void*)fwd_megakernel, 512, LDS_BYTES) != hipSuccess || per_cu < 1) { fprintf(stderr, "kernel_launch: occupancy query gave %d\n", per_cu); per_cu = 1; }
        (void)hipGetLastError();
        if (cus < 256) { fprintf(stderr, "kernel_launch: needs 256 CUs, found %d\n", cus); grid_blocks = -1; return; }
        grid_blocks = 256;
    }
    if (grid_blocks < 0) return;
    Params p{};
    p.x = (const float*)d_in[0]; p.meta = (const float*)d_in[1]; p.mix_gain = (const float*)d_in[2]; p.ab_w_in = (const float*)d_in[3];
    p.ab_q_gain = (const float*)d_in[4]; p.ab_k_gain = (const float*)d_in[5]; p.ab_w_out = (const float*)d_in[6]; p.c_w_in = (const float*)d_in[7];
    p.c_lb = (const float*)d_in[8]; p.c_o_gain = (const float*)d_in[9]; p.c_w_out = (const float*)d_in[10]; p.mlp_gain = (const float*)d_in[11];
    p.mlp_w1 = (const float*)d_in[12]; p.mlp_w2 = (const float*)d_in[13]; p.final_gain = (const float*)d_in[14];
    p.out = (float*)d_out; p.ws = (unsigned char*)d_ws;
    if (hipMemsetAsync((char*)d_ws + WS_BAR, 0, 8192, stream) != hipSuccess) { fprintf(stderr, "kernel_launch: memset failed\n"); return; }
    void* args[] = {&p};
    hipError_t e = hipLaunchCooperativeKernel((const void*)fwd_megakernel, dim3(grid_blocks), dim3(512), args, LDS_BYTES, stream);
    if (e != hipSuccess) fprintf(stderr, "kernel_launch: cooperative launch failed: %s (grid %d)\n", hipGetErrorString(e), grid_blocks);
}
```
